# Optimizing an MI355X kernel written in HIP

```python
import jax, jax.numpy as jnp
from jax import lax
import numpy as np


D_MODEL = 1024
BATCH = 16
SEQ = 2048
DEPTH = 2

GRID_W = 64
CTX_LEN = 256
N_MIXERS = 2
HEAD_DIM = 64
N_Q_HEADS = D_MODEL // HEAD_DIM
N_KV_HEADS = N_Q_HEADS // 4
GQA_GROUP = N_Q_HEADS // N_KV_HEADS
Q_DIM = N_Q_HEADS * HEAD_DIM
KV_DIM = N_KV_HEADS * HEAD_DIM
WINDOW = 128
ATTN_BLOCK = 128
ROPE_THETA = 10000.0
ROPE_AXIS_DIM = HEAD_DIM // 2
CONV_WIDTH = 3
D_FF_DENSE = 2816
N_EXPERTS = 8
TOP_K = 2
D_FF_EXPERT = 3584
MOE_BLOCK = 128
LN_EPS = 1e-5
MASK_VALUE = -1e30
DEEPNORM_ALPHA = (2 * DEPTH) ** 0.25
DEEPNORM_BETA = (8 * DEPTH) ** -0.25
N_ATTN_LAYERS = (DEPTH + N_MIXERS - 1) // N_MIXERS
N_CONV_LAYERS = DEPTH // N_MIXERS
N_DENSE_LAYERS = (DEPTH + 1) // 2
N_MOE_LAYERS = DEPTH // 2

kernel_name = 'hybrid_window_gqa_shortconv_moe_dit'


def layer_norm(x, g, b):
    xf = x.astype(jnp.float32)
    mu = xf.mean(-1, keepdims=True)
    var = jnp.square(xf - mu).mean(-1, keepdims=True)
    return ((xf - mu) * lax.rsqrt(var + LN_EPS) * g.astype(jnp.float32) + b.astype(jnp.float32)).astype(x.dtype)


def axial_rope_tables(rows_count, dtype):
    rows = jnp.repeat(jnp.arange(rows_count, dtype=jnp.float32), GRID_W)
    cols = jnp.tile(jnp.arange(GRID_W, dtype=jnp.float32), rows_count)
    inv_freq = ROPE_THETA ** (-jnp.arange(0, ROPE_AXIS_DIM, 2, dtype=jnp.float32) / ROPE_AXIS_DIM)
    ar = rows[:, None] * inv_freq
    ac = cols[:, None] * inv_freq
    ang = jnp.concatenate([ar, ar, ac, ac], axis=-1)
    return jnp.cos(ang).astype(dtype), jnp.sin(ang).astype(dtype)


def apply_rope(x, cos, sin):
    xr = x.reshape(x.shape[:-1] + (2, 2, ROPE_AXIS_DIM // 2))
    rot = jnp.stack([-xr[..., 1, :], xr[..., 0, :]], axis=-2).reshape(x.shape)
    return x * cos[:, None, :] + rot * sin[:, None, :]


def sink_softmax(logits, sink):
    m = jnp.maximum(logits.max(-1, keepdims=True), sink)
    p = jnp.exp(logits - m)
    return p / (p.sum(-1, keepdims=True) + jnp.exp(sink - m))


def windowed_latent_attention(q, k, v, k_ctx, v_ctx, sink):
    B, S = q.shape[:2]
    n_ctx = k_ctx.shape[1]
    n_blocks = S // ATTN_BLOCK
    span = ATTN_BLOCK + 2 * WINDOW
    pad = ((0, 0), (WINDOW, WINDOW), (0, 0), (0, 0))
    k_pad = jnp.pad(k, pad)
    v_pad = jnp.pad(v, pad)
    scale = HEAD_DIM ** -0.5

    def block(i):
        s0 = i * ATTN_BLOCK
        qb = lax.dynamic_slice_in_dim(q, s0, ATTN_BLOCK, axis=1)
        kb = lax.dynamic_slice_in_dim(k_pad, s0, span, axis=1)
        vb = lax.dynamic_slice_in_dim(v_pad, s0, span, axis=1)
        q_pos = s0 + jnp.arange(ATTN_BLOCK)
        k_pos = s0 - WINDOW + jnp.arange(span)
        valid = (jnp.abs(q_pos[:, None] - k_pos[None, :]) <= WINDOW) & (k_pos >= 0) & (k_pos < S)
        s_win = jnp.einsum('bqkgd,bnkd->bkgqn', qb, kb).astype(jnp.float32) * scale
        s_win = jnp.where(valid, s_win, MASK_VALUE)
        s_ctx = jnp.einsum('bqkgd,bckd->bkgqc', qb, k_ctx).astype(jnp.float32) * scale
        probs = sink_softmax(jnp.concatenate([s_ctx, s_win], axis=-1), sink)
        o = (jnp.einsum('bkgqc,bckd->bqkgd', probs[..., :n_ctx], v_ctx.astype(jnp.float32))
             + jnp.einsum('bkgqn,bnkd->bqkgd', probs[..., n_ctx:], vb.astype(jnp.float32)))
        return o.astype(q.dtype)

    out = lax.map(block, jnp.arange(n_blocks))
    return jnp.moveaxis(out, 0, 1).reshape(B, S, Q_DIM)


def context_attention(q, k, v, sink):
    B, C = q.shape[:2]
    s = jnp.einsum('bqkgd,bckd->bkgqc', q, k).astype(jnp.float32) * HEAD_DIM ** -0.5
    o = jnp.einsum('bkgqc,bckd->bqkgd', sink_softmax(s, sink), v.astype(jnp.float32))
    return o.astype(q.dtype).reshape(B, C, Q_DIM)


def attention_mixer(h, hc, w_qkv, w_o, sinks, cos, sin, update_ctx):
    B, S, _ = h.shape
    C = hc.shape[1]
    q, k, v = jnp.split(h @ w_qkv, [Q_DIM, Q_DIM + KV_DIM], axis=-1)
    q = apply_rope(q.reshape(B, S, N_Q_HEADS, HEAD_DIM), cos, sin).reshape(B, S, N_KV_HEADS, GQA_GROUP, HEAD_DIM)
    k = apply_rope(k.reshape(B, S, N_KV_HEADS, HEAD_DIM), cos, sin)
    v = v.reshape(B, S, N_KV_HEADS, HEAD_DIM)
    if update_ctx:
        q_c, k_c, v_c = jnp.split(hc @ w_qkv, [Q_DIM, Q_DIM + KV_DIM], axis=-1)
    else:
        k_c, v_c = jnp.split(hc @ w_qkv[:, Q_DIM:], [KV_DIM], axis=-1)
    k_c = k_c.reshape(B, C, N_KV_HEADS, HEAD_DIM)
    v_c = v_c.reshape(B, C, N_KV_HEADS, HEAD_DIM)
    sink = sinks.astype(jnp.float32).reshape(N_KV_HEADS, GQA_GROUP, 1, 1)
    out = windowed_latent_attention(q, k, v, k_c, v_c, sink) @ w_o
    out_c = None
    if update_ctx:
        q_c = q_c.reshape(B, C, N_KV_HEADS, GQA_GROUP, HEAD_DIM)
        out_c = context_attention(q_c, k_c, v_c, sink) @ w_o
    return out, out_c


def short_conv_mixer(h, w_in, conv_w, w_out):
    S = h.shape[1]
    b_gate, c_gate, val = jnp.split(h @ w_in, 3, axis=-1)
    u = c_gate * val
    half = CONV_WIDTH // 2
    u_pad = jnp.pad(u, ((0, 0), (half, half), (0, 0)))
    y = sum(conv_w[j] * u_pad[:, j:j + S] for j in range(CONV_WIDTH))
    return (b_gate * y) @ w_out


def swiglu(h, w1, w3, w2):
    return (jax.nn.silu(h @ w1) * (h @ w3)) @ w2


def moe_swiglu(h, w_router, w1, w3, w2):
    T, D = h.shape
    logits = (h @ w_router).astype(jnp.float32)
    top_logit, top_e = lax.top_k(logits, TOP_K)
    gates = jax.nn.softmax(top_logit, axis=-1)
    e_flat = top_e.reshape(-1).astype(jnp.int32)
    tok_flat = jnp.repeat(jnp.arange(T, dtype=jnp.int32), TOP_K)
    g_flat = gates.reshape(-1)
    order = jnp.argsort(e_flat)
    e_s, tok_s, g_s = e_flat[order], tok_flat[order], g_flat[order]
    counts = jnp.zeros((N_EXPERTS,), jnp.int32).at[e_flat].add(1)
    starts = jnp.cumsum(counts) - counts
    padded = (counts + MOE_BLOCK - 1) // MOE_BLOCK * MOE_BLOCK
    pends = jnp.cumsum(padded)
    pstarts = pends - padded
    dest = pstarts[e_s] + jnp.arange(T * TOP_K, dtype=jnp.int32) - starts[e_s]
    n_blocks = -(-(T * TOP_K) // MOE_BLOCK) + N_EXPERTS
    n_rows = n_blocks * MOE_BLOCK
    row_tok = jnp.full((n_rows,), T, jnp.int32).at[dest].set(tok_s)
    row_gate = jnp.zeros((n_rows,), jnp.float32).at[dest].set(g_s)
    block_e = jnp.minimum(jnp.searchsorted(pends, jnp.arange(n_blocks, dtype=jnp.int32) * MOE_BLOCK, side='right'), N_EXPERTS - 1)
    h_pad = jnp.concatenate([h, jnp.zeros((1, D), h.dtype)], axis=0)
    xb = h_pad[row_tok].reshape(n_blocks, MOE_BLOCK, D)

    def expert_block(args):
        xblk, e = args
        return swiglu(xblk, w1[e], w3[e], w2[e])

    yb = lax.map(expert_block, (xb, block_e)).reshape(n_rows, D)
    y = jax.ops.segment_sum(yb * row_gate[:, None], row_tok, num_segments=T + 1)
    return y[:T].astype(h.dtype)


def setup_inputs(seed: int = 0) -> dict:
    key = jax.random.key(seed)
    ks = jax.random.split(key, 22)
    D = D_MODEL

    def nrm(k, shape, scale):
        return jax.random.normal(k, shape, jnp.float32) * scale

    return {
        'x': nrm(ks[0], (BATCH, SEQ, D), 1.0),
        'c': nrm(ks[1], (BATCH, D), 1.0),
        'ctx': nrm(ks[2], (BATCH, CTX_LEN, D), 1.0),
        'c_ctx': nrm(ks[3], (D,), 1.0),
        'w_mod': nrm(ks[4], (DEPTH, D, 6 * D), 0.5 * D ** -0.5),
        'b_mod': nrm(ks[5], (DEPTH, 6 * D), 0.01),
        'ln_g': 1.0 + nrm(ks[6], (DEPTH, 2, D), 0.02),
        'ln_b': nrm(ks[7], (DEPTH, 2, D), 0.02),
        'attn_w_qkv': nrm(ks[8], (N_ATTN_LAYERS, D, Q_DIM + 2 * KV_DIM), D ** -0.5),
        'attn_w_o': nrm(ks[9], (N_ATTN_LAYERS, Q_DIM, D), Q_DIM ** -0.5 * DEEPNORM_BETA),
        'attn_sink': nrm(ks[10], (N_ATTN_LAYERS, N_Q_HEADS), 0.5),
        'conv_w_in': nrm(ks[11], (N_CONV_LAYERS, D, 3 * D), D ** -0.5),
        'conv_w': nrm(ks[12], (N_CONV_LAYERS, CONV_WIDTH, D), CONV_WIDTH ** -0.5),
        'conv_w_out': nrm(ks[13], (N_CONV_LAYERS, D, D), D ** -0.5 * DEEPNORM_BETA),
        'ffn_w1': nrm(ks[14], (N_DENSE_LAYERS, D, D_FF_DENSE), D ** -0.5),
        'ffn_w3': nrm(ks[15], (N_DENSE_LAYERS, D, D_FF_DENSE), D ** -0.5),
        'ffn_w2': nrm(ks[16], (N_DENSE_LAYERS, D_FF_DENSE, D), D_FF_DENSE ** -0.5 * DEEPNORM_BETA),
        'moe_router': nrm(ks[17], (N_MOE_LAYERS, D, N_EXPERTS), D ** -0.5),
        'moe_w1': nrm(ks[18], (N_MOE_LAYERS, N_EXPERTS, D, D_FF_EXPERT), D ** -0.5),
        'moe_w3': nrm(ks[19], (N_MOE_LAYERS, N_EXPERTS, D, D_FF_EXPERT), D ** -0.5),
        'moe_w2': nrm(ks[20], (N_MOE_LAYERS, N_EXPERTS, D_FF_EXPERT, D), D_FF_EXPERT ** -0.5 * DEEPNORM_BETA),
    }


def reference(x, c, ctx, c_ctx, w_mod, b_mod, ln_g, ln_b, attn_w_qkv, attn_w_o, attn_sink,
              conv_w_in, conv_w, conv_w_out, ffn_w1, ffn_w3, ffn_w2,
              moe_router, moe_w1, moe_w3, moe_w2):
    B, S, D = x.shape
    ROWS = S // GRID_W
    cos, sin = axial_rope_tables(ROWS, x.dtype)
    silu_c = jax.nn.silu(c)
    silu_cc = jax.nn.silu(c_ctx)
    xc = ctx
    for i in range(DEPTH):
        mi = i // N_MIXERS
        fi = i // 2
        is_attn = i % N_MIXERS == 0
        is_dense = i % 2 == 0
        update_ctx = any(j % N_MIXERS == 0 for j in range(i + 1, DEPTH))

        sh1, sc1, g1, sh2, sc2, g2 = jnp.split((silu_c @ w_mod[i] + b_mod[i])[:, None, :], 6, axis=-1)
        h = x * (1 + sc1) + sh1
        if is_attn or update_ctx:
            csh1, csc1, cg1, csh2, csc2, cg2 = jnp.split(silu_cc @ w_mod[i] + b_mod[i], 6)
            hc = xc * (1 + csc1) + csh1

        if is_attn:
            mix, mix_c = attention_mixer(h, hc, attn_w_qkv[mi], attn_w_o[mi], attn_sink[mi], cos, sin, update_ctx)
        else:
            mix = short_conv_mixer(h, conv_w_in[mi], conv_w[mi], conv_w_out[mi])
            mix_c = short_conv_mixer(hc, conv_w_in[mi], conv_w[mi], conv_w_out[mi]) if update_ctx else None
        x = layer_norm(DEEPNORM_ALPHA * x + g1 * mix, ln_g[i, 0], ln_b[i, 0])
        if update_ctx:
            xc = layer_norm(DEEPNORM_ALPHA * xc + cg1 * mix_c, ln_g[i, 0], ln_b[i, 0])

        h = x * (1 + sc2) + sh2
        if update_ctx:
            hc = xc * (1 + csc2) + csh2
        if is_dense:
            ff = swiglu(h, ffn_w1[fi], ffn_w3[fi], ffn_w2[fi])
            ff_c = swiglu(hc, ffn_w1[fi], ffn_w3[fi], ffn_w2[fi]) if update_ctx else None
        else:
            tokens = h.reshape(-1, D)
            n_c = 0
            if update_ctx:
                n_c = hc.shape[0] * hc.shape[1]
                tokens = jnp.concatenate([hc.reshape(-1, D), tokens], axis=0)
            y_all = moe_swiglu(tokens, moe_router[fi], moe_w1[fi], moe_w3[fi], moe_w2[fi])
            ff = y_all[n_c:].reshape(h.shape)
            ff_c = y_all[:n_c].reshape(hc.shape) if update_ctx else None
        x = layer_norm(DEEPNORM_ALPHA * x + g2 * ff, ln_g[i, 1], ln_b[i, 1])
        if update_ctx:
            xc = layer_norm(DEEPNORM_ALPHA * xc + cg2 * ff_c, ln_g[i, 1], ln_b[i, 1])
    return x
```

```cpp
#include <hip/hip_runtime.h>
#include <cstdio>
#include <cstdint>

#ifndef MK_ONE_LAUNCH
#define MK_ONE_LAUNCH 1
#endif

#define LAS __attribute__((address_space(3)))
#define GAS __attribute__((address_space(1)))
typedef unsigned short bf16_t;
typedef short bf16x8 __attribute__((ext_vector_type(8)));
typedef float f32x4 __attribute__((ext_vector_type(4)));
typedef float f32x16 __attribute__((ext_vector_type(16)));
typedef unsigned u32x4 __attribute__((ext_vector_type(4)));
typedef unsigned u32x2 __attribute__((ext_vector_type(2)));
typedef int v8i __attribute__((ext_vector_type(8)));
typedef int v4i __attribute__((ext_vector_type(4)));

constexpr int NB = 16, SEQ = 2048, D = 1024, T = NB * SEQ, CTX = 256, TC = NB * CTX;
constexpr int NQKV = 1536, DFF = 2816, NE = 8, DFE = 3584;
constexpr int HROWS = T + TC;
constexpr float LN_EPS = 1e-5f;
constexpr float ALPHA = 1.41421356237309515f;
constexpr int MAXP = 264;
constexpr int NWAVES = 8;

constexpr size_t MiB = 1u << 20;
constexpr size_t WS_CTL = 0, CTL_ZERO_BYTES = 128 * 1024;
constexpr size_t WS_MOEQ = 60 * 1024;
constexpr size_t WS_CMAX13 = 64 * 1024;
constexpr size_t WS_CMAXCIN = WS_CMAX13 + 5632 * 4;
constexpr size_t WS_MODV = 1 * MiB;
constexpr size_t WS_ROPE = WS_MODV + 2 * 17 * 6144 * 4;
constexpr size_t WS_WGCNT = WS_ROPE + 64 * 16 * 2 * 4;
constexpr size_t WS_PSTART = WS_WGCNT + 256 * 8 * 4;
constexpr size_t WS_TOKE = 2 * MiB;
constexpr size_t WS_TOKG = WS_TOKE + (size_t)T * 16;
constexpr size_t WS_TOKP = WS_TOKG + (size_t)T * 8;
constexpr size_t WS_RS1 = 3 * MiB;
constexpr size_t WS_RS2 = WS_RS1 + (size_t)T * 4;
constexpr size_t WS_W = 4 * MiB;
constexpr size_t WS_WQKV = WS_W;
constexpr size_t WS_WO = WS_WQKV + (size_t)NQKV * D * 2;
constexpr size_t WS_W13 = WS_WO + (size_t)D * D * 2;
constexpr size_t WS_W2 = WS_W13 + (size_t)2 * DFF * D * 2;
constexpr size_t WS_WCIN = WS_W2 + (size_t)D * DFF * 2;
constexpr size_t WS_WCOUT = WS_WCIN + (size_t)3 * D * D * 2;
constexpr size_t WS_WM13 = WS_WCOUT + (size_t)D * D * 2;
constexpr size_t WS_WM2 = WS_WM13 + (size_t)NE * 2 * DFE * D;
constexpr size_t WS_WEND = WS_WM2 + (size_t)NE * D * DFE;
constexpr size_t WS_H = (WS_WEND + MiB - 1) / MiB * MiB;
constexpr size_t WS_MIX = WS_H + (size_t)HROWS * D * 2;
constexpr size_t WS_A = WS_MIX + (size_t)T * D * 2;
constexpr size_t WS_Q = WS_A, WS_K = WS_Q + (size_t)T * D * 2, WS_V = WS_K + (size_t)T * 256 * 2, WS_KC = WS_V + (size_t)T * 256 * 2, WS_VC = WS_KC + (size_t)TC * 256 * 2;
constexpr size_t WS_AO = WS_VC + (size_t)TC * 256 * 2;
constexpr size_t WS_ACT = WS_A;
constexpr size_t WS_BG = WS_A, WS_U = WS_BG + (size_t)T * D * 2, WS_Z = WS_U + (size_t)T * D * 2;
constexpr size_t WS_XB = WS_Z + (size_t)T * D * 2;
constexpr size_t WS_Y = WS_H;
constexpr size_t WS_HS8 = WS_A;
constexpr size_t WS_MACT8 = WS_HS8 + (size_t)MAXP * 256 * D;
constexpr size_t WS_H3F8 = WS_MACT8;
constexpr size_t WS_END = WS_MACT8 + (size_t)MAXP * 256 * DFE;
static_assert(WS_Y + (size_t)MAXP * 256 * D * 2 <= WS_A, "sorted y rows fit over h | mix");
static_assert(WS_AO + (size_t)T * D * 2 <= WS_END && WS_ACT + (size_t)T * DFF * 2 <= WS_END && WS_Z + (size_t)T * D * 2 <= WS_END, "map");
static_assert(WS_XB + (size_t)T * D * 2 <= WS_END, "map");
static_assert(WS_END <= 615000000ull, "workspace too large");

constexpr int RING_BYTES = 131072;
constexpr int MISC_OFF = RING_BYTES;
constexpr int LDS_BYTES = 147456;

#define DPPF(old, v, ctrl, rm) __builtin_bit_cast(float, __builtin_amdgcn_update_dpp(__builtin_bit_cast(int, (float)(old)), __builtin_bit_cast(int, (float)(v)), (ctrl), (rm), 0xF, false))
__device__ __forceinline__ unsigned cvt_pk_bf16(float lo, float hi) { unsigned r; asm volatile("v_cvt_pk_bf16_f32 %0, %1, %2" : "=v"(r) : "v"(lo), "v"(hi)); return r; }
__device__ __forceinline__ unsigned cvt_pk4_fp8(float a, float b, float c, float d) { int w = __builtin_amdgcn_cvt_pk_fp8_f32(a, b, 0, false); w = __builtin_amdgcn_cvt_pk_fp8_f32(c, d, w, true); return (unsigned)w; }
__device__ __forceinline__ unsigned pk4_i8(float a, float b, float c, float d) {
    const int ia = (int)__builtin_rintf(a), ib = (int)__builtin_rintf(b), ic = (int)__builtin_rintf(c), id = (int)__builtin_rintf(d);
    return (unsigned)(ia & 255) | ((unsigned)(ib & 255) << 8) | ((unsigned)(ic & 255) << 16) | ((unsigned)id << 24); }
__device__ __forceinline__ float wave_max(float v) {
    v = fmaxf(v, DPPF(v, v, 0xB1, 0xF)); v = fmaxf(v, DPPF(v, v, 0x4E, 0xF)); v = fmaxf(v, DPPF(v, v, 0x141, 0xF)); v = fmaxf(v, DPPF(v, v, 0x140, 0xF));
    v = fmaxf(v, DPPF(v, v, 0x142, 0xA)); v = fmaxf(v, DPPF(v, v, 0x143, 0xC));
    return __builtin_bit_cast(float, __builtin_amdgcn_readlane(__builtin_bit_cast(int, v), 63));
}
__device__ __forceinline__ float bf_lo(unsigned w) { return __uint_as_float(w << 16); }
__device__ __forceinline__ float bf_hi(unsigned w) { return __uint_as_float(w & 0xffff0000u); }
__device__ __forceinline__ float wave_sum(float v) {
    v += DPPF(0.f, v, 0xB1, 0xF); v += DPPF(0.f, v, 0x4E, 0xF); v += DPPF(0.f, v, 0x141, 0xF); v += DPPF(0.f, v, 0x140, 0xF);
    v += DPPF(0.f, v, 0x142, 0xA); v += DPPF(0.f, v, 0x143, 0xC);
    return __builtin_bit_cast(float, __builtin_amdgcn_readlane(__builtin_bit_cast(int, v), 63));
}
#define LDS_WAIT() asm volatile("s_waitcnt lgkmcnt(0)" ::: "memory")
#define VM_WAIT() asm volatile("s_waitcnt vmcnt(0)" ::: "memory")

#define XB_TMO      128
#define XB_XCNT(j)  (256  + 64 * (j))
#define XB_XSUB(j)  (1280 + 64 * (j))
#define XB_XGEN(j)  (2304 + 64 * (j))
#define XB_TOP      3328
#define XB_TOPGEN   3392
#define XCD_BAR_WORDS 3456
#define XB_SPIN_CAP (1u << 18)
__device__ __forceinline__ unsigned xb_ld(unsigned* p)              { return __hip_atomic_load(p, __ATOMIC_RELAXED, __HIP_MEMORY_SCOPE_AGENT); }
__device__ __forceinline__ unsigned xb_add(unsigned* p, unsigned v) { return __hip_atomic_fetch_add(p, v, __ATOMIC_RELAXED, __HIP_MEMORY_SCOPE_AGENT); }
__device__ __forceinline__ unsigned xb_xcc_id() { return (unsigned)__builtin_amdgcn_s_getreg((3 << 11) | 20) & 0xFu; }
#define XB_SPIN(cond, bar) do { unsigned _sp = 0; while (cond) { __builtin_amdgcn_s_sleep(1); \
    if ((++_sp & 255u) == 0u) { if (xb_ld(&(bar)[XB_TMO])) break; if (_sp > XB_SPIN_CAP) { atomicAdd(&(bar)[XB_TMO], 1u); break; } } } } while (0)
struct XcdBarrier { unsigned* bar; unsigned x; volatile LAS unsigned* st; };
__device__ __forceinline__ XcdBarrier xcd_barrier_post(unsigned* bar, volatile LAS unsigned* st) {
    XcdBarrier b; b.bar = bar; b.x = xb_xcc_id(); b.st = st;
    if (threadIdx.x == 0) (void)xb_add(&bar[XB_XCNT(b.x)], 1u);
    return b;
}
__device__ __forceinline__ void xcd_barrier_complete(unsigned* bar, unsigned x, unsigned& nloc, unsigned& nx) {
    const unsigned G = gridDim.x * gridDim.y * gridDim.z;
    unsigned sum, cnt, mine, sp = 0u;
    for (;;) {
        sum = 0u; cnt = 0u; mine = 0u;
#pragma unroll
        for (unsigned j = 0; j < 16; ++j) { const unsigned c = xb_ld(&bar[XB_XCNT(j)]); sum += c; cnt += (c > 0u) ? 1u : 0u; mine = (j == x) ? c : mine; }
        if (sum == G) break;
        __builtin_amdgcn_s_sleep(1);
        if ((++sp & 255u) == 0u) { if (xb_ld(&bar[XB_TMO])) break; if (sp > XB_SPIN_CAP) { atomicAdd(&bar[XB_TMO], 1u); break; } }
    }
    nloc = mine > 0u ? mine : 1u; nx = cnt > 0u ? cnt : 1u;
}
__device__ __forceinline__ void xcd_barrier(const XcdBarrier& b) {
    asm volatile("s_waitcnt vmcnt(0)" ::: "memory");
    __syncthreads();
    if (threadIdx.x == 0) {
        unsigned* bar = b.bar;
        __builtin_amdgcn_s_waitcnt(0);
        unsigned nloc = b.st[0], nx = b.st[1];
        if (nloc == 0u) { xcd_barrier_complete(bar, b.x, nloc, nx); b.st[0] = nloc; b.st[1] = nx; }
        const unsigned old = xb_add(&bar[XB_XSUB(b.x)], 1u);
        const unsigned gen = old / nloc;
        if (old + 1u == (gen + 1u) * nloc) {
            __builtin_amdgcn_fence(__ATOMIC_RELEASE, "agent");
            asm volatile("s_waitcnt vmcnt(0)" ::: "memory");
            const unsigned og = xb_add(&bar[XB_TOP], 1u);
            const unsigned tg = og / nx;
            if (og + 1u == (tg + 1u) * nx) xb_add(&bar[XB_TOPGEN], 1u);
            else XB_SPIN(xb_ld(&bar[XB_TOPGEN]) == tg, bar);
            __builtin_amdgcn_fence(__ATOMIC_ACQUIRE, "agent");
            xb_add(&bar[XB_XGEN(b.x)], 1u);
            asm volatile("s_waitcnt vmcnt(0)" ::: "memory");
        } else {
            XB_SPIN(xb_ld(&bar[XB_XGEN(b.x)]) == gen, bar);
            __builtin_amdgcn_fence(__ATOMIC_ACQUIRE, "agent");
            asm volatile("s_waitcnt vmcnt(0)" ::: "memory");
        }
    }
    __syncthreads();
}

__device__ __forceinline__ bool xcd_barrier_arrive(const XcdBarrier& b) {
    asm volatile("s_waitcnt vmcnt(0)" ::: "memory");
    __syncthreads();
    if (threadIdx.x == 0) {
        unsigned* bar = b.bar;
        __builtin_amdgcn_s_waitcnt(0);
        unsigned nloc = b.st[0], nx = b.st[1];
        if (nloc == 0u) { xcd_barrier_complete(bar, b.x, nloc, nx); b.st[0] = nloc; b.st[1] = nx; }
        const unsigned old = xb_add(&bar[XB_XSUB(b.x)], 1u);
        const unsigned gen = old / nloc;
        unsigned role = 0u, tg = 0u;
        if (old + 1u == (gen + 1u) * nloc) {
            __builtin_amdgcn_fence(__ATOMIC_RELEASE, "agent");
            asm volatile("s_waitcnt vmcnt(0)" ::: "memory");
            const unsigned og = xb_add(&bar[XB_TOP], 1u);
            tg = og / nx; role = 1u;
            if (og + 1u == (tg + 1u) * nx) { xb_add(&bar[XB_TOPGEN], 1u); role = 2u; }
        }
        b.st[2] = gen; b.st[3] = tg; b.st[4] = role;
    }
    __syncthreads();
    return b.st[4] != 0u;
}
__device__ __forceinline__ void xcd_barrier_wait(const XcdBarrier& b) {
    if (threadIdx.x == 0) {
        unsigned* bar = b.bar;
        const unsigned gen = b.st[2], tg = b.st[3], role = b.st[4];
        if (role != 0u) {
            if (role == 1u) XB_SPIN(xb_ld(&bar[XB_TOPGEN]) == tg, bar);
            __builtin_amdgcn_fence(__ATOMIC_ACQUIRE, "agent");
            xb_add(&bar[XB_XGEN(b.x)], 1u);
            asm volatile("s_waitcnt vmcnt(0)" ::: "memory");
        } else {
            XB_SPIN(xb_ld(&bar[XB_XGEN(b.x)]) == gen, bar);
            __builtin_amdgcn_fence(__ATOMIC_ACQUIRE, "agent");
            asm volatile("s_waitcnt vmcnt(0)" ::: "memory");
        }
    }
    __syncthreads();
}

namespace pg8 {
constexpr int BM = 256, BK = 64, HALF = 128, HTB = HALF * BK * 2, STAGE_BYTES = 8 * HTB, NXCD = 8, WGM = 8;
__host__ __device__ __forceinline__ int lds_byte(int r, int c) { const int st = (r >> 4) * 2 + (c >> 5), rr = r & 15, cc = c & 31, ob = rr * 64 + cc * 2; return st * 1024 + (ob ^ (((ob >> 9) & 1) << 5)); }
__host__ __device__ __forceinline__ void stage_rc(int b, int& R, int& C) { const int st = b / 1024, sb = b % 1024, swz = sb ^ (((sb >> 9) & 1) << 5); R = (st >> 1) * 16 + swz / 64; C = (st & 1) * 32 + (swz % 64) / 2; }
__host__ __device__ __forceinline__ int perm32(int rho) { const int n = rho >> 4, i = rho & 15; return 8 * (i >> 2) + 4 * n + (i & 3); }

__host__ __device__ __forceinline__ int perm32b(int rho) { const int n = rho >> 4, i = rho & 15, f = i >> 2; return 16 * (f & 1) + 8 * (f >> 1) + 4 * n + (i & 3); }
struct Unit { int am, bn, om, on, ko; };
struct Gemm { const bf16_t* A; const bf16_t* Bt; int K; int ntt; };

__device__ __forceinline__ void tile_of(int L, int nM, int nN, int& pm, int& pn) {
    const int nwg = nM * nN; int wgid = L;
    { const int q = nwg / NXCD, r = nwg % NXCD, xcd = wgid % NXCD, off = wgid / NXCD; wgid = (xcd < r ? xcd * (q + 1) : r * (q + 1) + (xcd - r) * q) + off; }
    const int nig = WGM * nN, gid = wgid / nig, fm = gid * WGM, gsz = (nM - fm) < WGM ? (nM - fm) : WGM;
    pm = fm + ((wgid % nig) % gsz); pn = (wgid % nig) / gsz;
}
struct StaticOrder {
    static constexpr bool HAS_KO = false;
    int nM, nN, G, c;
    __device__ __forceinline__ void init(int nM_, int nN_, int G_, int c_) { nM = nM_; nN = nN_; G = G_; c = c_; }
    __device__ __forceinline__ bool next(int i, Unit& u) const {
        const int L = i * G + c; if (L >= nM * nN) return false;
        int pm, pn; tile_of(L, nM, nN, pm, pn); u.am = pm; u.om = pm; u.bn = pn; u.on = pn; return true;
    }
};
struct QkvOrder {
    static constexpr bool HAS_KO = false;
    int G, c;
    __device__ __forceinline__ bool next(int i, Unit& u) const {
        const int L = i * G + c; if (L >= 800) return false;
        int pm, pn;
        if (L < 768) tile_of(L, 128, 6, pm, pn); else { const int j = L - 768; pm = 128 + (j >> 1); pn = 4 + (j & 1); }
        u.am = pm; u.om = pm; u.bn = pn; u.on = pn; return true;
    }
};
struct MoeOrder {
    static constexpr bool HAS_KO = false;
    int np, nN, G, c; int pe0, pe1, pe2, pe3, pe4, pe5, pe6; int lim;
    __device__ __forceinline__ bool next(int i, Unit& u) const {
        const int L = i * G + c; if (L >= np * nN || L >= lim) return false;
        int pm, pn; tile_of(L, np, nN, pm, pn);
        const int e = (pm >= pe0) + (pm >= pe1) + (pm >= pe2) + (pm >= pe3) + (pm >= pe4) + (pm >= pe5) + (pm >= pe6);
        u.bn = e * nN + pn; u.on = pn; u.am = pm; u.om = pm;
        return true;
    }
};

struct PieceOrder {
    static constexpr bool HAS_KO = true;
    int np, G, c, l0, npc, spl, ktp; int pe0, pe1, pe2, pe3, pe4, pe5, pe6;
    __device__ __forceinline__ bool next(int i, Unit& u) const {
        if (i != 0 || c >= npc) return false;
        const int jt = c / spl, sp = c - jt * spl;
        int pm, pn; tile_of(l0 + jt, np, 4, pm, pn);
        const int e = (pm >= pe0) + (pm >= pe1) + (pm >= pe2) + (pm >= pe3) + (pm >= pe4) + (pm >= pe5) + (pm >= pe6);
        u.bn = e * 4 + pn; u.am = pm; u.om = c; u.on = 0; u.ko = sp * ktp;
        return true;
    }
};

struct EpiPlain {
    static constexpr bool PERM2 = false;
    bf16_t* O; int ldc; float sc;
    __device__ __forceinline__ void operator()(const f32x4 (&acc)[2][2][4][2], const Unit& u, int wr, int wc, int fr, int fq) const {
        const int row0 = u.om * BM + wr * 64 + fr, col0 = u.on * BM + wc * 32 + 8 * fq;
#pragma unroll
        for (int ai = 0; ai < 2; ++ai)
#pragma unroll
            for (int m = 0; m < 4; ++m) { bf16_t* rowp = O + (size_t)(row0 + ai * HALF + m * 16) * ldc + col0;
#pragma unroll
                for (int bj = 0; bj < 2; ++bj) { const f32x4 v0 = acc[ai][bj][m][0] * sc, v1 = acc[ai][bj][m][1] * sc;
                    u32x4 w; w.x = cvt_pk_bf16(v0[0], v0[1]); w.y = cvt_pk_bf16(v0[2], v0[3]); w.z = cvt_pk_bf16(v1[0], v1[1]); w.w = cvt_pk_bf16(v1[2], v1[3]);
                    *(u32x4*)(rowp + bj * HALF) = w; } }
    }
};
struct EpiPartial {
    static constexpr bool PERM2 = false;
    float* O; float sc;
    __device__ __forceinline__ void operator()(const f32x4 (&acc)[2][2][4][2], const Unit& u, int wr, int wc, int fr, int fq) const {
        float* base = O + (size_t)u.om * (BM * BM);
        const int lo = (wr * 64 + fr) * BM + wc * 32 + 8 * fq;
#pragma unroll
        for (int ai = 0; ai < 2; ++ai)
#pragma unroll
            for (int m = 0; m < 4; ++m)
#pragma unroll
                for (int bj = 0; bj < 2; ++bj)
#pragma unroll
                    for (int n = 0; n < 2; ++n) *(f32x4*)(base + (lo + (ai * HALF + m * 16) * BM + bj * HALF + 4 * n)) = acc[ai][bj][m][n] * sc;
    }
};
__device__ __forceinline__ float silu_f(float a) { return a * __builtin_amdgcn_rcpf(1.0f + __builtin_amdgcn_exp2f(-1.44269504089f * a)); }
typedef float f32x2 __attribute__((ext_vector_type(2)));
__device__ __forceinline__ f32x2 swiglu_pk(f32x2 x, f32x2 y, f32x2 c1, f32x2 c2) {
    const f32x2 m1 = x * c1; f32x2 e; e.x = __builtin_amdgcn_exp2f(m1.x); e.y = __builtin_amdgcn_exp2f(m1.y);
    const f32x2 d = e + 1.0f; f32x2 r; r.x = __builtin_amdgcn_rcpf(d.x); r.y = __builtin_amdgcn_rcpf(d.y);
    return ((x * y) * r) * c2;
}
struct EpiSwiGLU {
    static constexpr bool PERM2 = false;
    bf16_t* O; int ldc;
    __device__ __forceinline__ void operator()(const f32x4 (&acc)[2][2][4][2], const Unit& u, int wr, int wc, int fr, int fq) const {
        const int row0 = u.om * BM + wr * 64 + fr, col0 = u.on * HALF + wc * 32 + 8 * fq;
#pragma unroll
        for (int ai = 0; ai < 2; ++ai)
#pragma unroll
            for (int m = 0; m < 4; ++m) { bf16_t* rowp = O + (size_t)(row0 + ai * HALF + m * 16) * ldc + col0;
                f32x4 o0, o1;
#pragma unroll
                for (int j = 0; j < 4; ++j) { o0[j] = silu_f(acc[ai][0][m][0][j]) * acc[ai][1][m][0][j]; o1[j] = silu_f(acc[ai][0][m][1][j]) * acc[ai][1][m][1][j]; }
                u32x4 w; w.x = cvt_pk_bf16(o0[0], o0[1]); w.y = cvt_pk_bf16(o0[2], o0[3]); w.z = cvt_pk_bf16(o1[0], o1[1]); w.w = cvt_pk_bf16(o1[2], o1[3]);
                *(u32x4*)rowp = w; }
    }
};
struct EpiSwiGLU8 {
    static constexpr bool PERM2 = true;
    unsigned char* O; int ldc; float ds;
    __device__ __forceinline__ void operator()(const f32x4 (&acc)[2][2][4][2], const Unit& u, int wr, int wc, int fr, int fq) const {
        unsigned char* blk = O + (size_t)(u.om * (ldc >> 7) + u.on) * (BM * 128);
        const int lo = (wr * 64 + fr + ((fq >> 1) ? 16 : 0)) * 128 + wc * 32 + 16 * (fq & 1);
        const f32x2 c1 = {-1.44269504089f * ds, -1.44269504089f * ds}, c2 = {ds * ds, ds * ds};
#pragma unroll
        for (int ai = 0; ai < 2; ++ai)
#pragma unroll
            for (int mp = 0; mp < 2; ++mp) {
                u32x2 w[2];
#pragma unroll
                for (int mo = 0; mo < 2; ++mo) { const int m = 2 * mp + mo;
                    const f32x4 xa0 = acc[ai][0][m][0], xb0 = acc[ai][1][m][0], xa1 = acc[ai][0][m][1], xb1 = acc[ai][1][m][1];
                    const f32x2 p0 = swiglu_pk((f32x2){xa0[0], xa0[1]}, (f32x2){xb0[0], xb0[1]}, c1, c2), p1 = swiglu_pk((f32x2){xa0[2], xa0[3]}, (f32x2){xb0[2], xb0[3]}, c1, c2);
                    const f32x2 p2 = swiglu_pk((f32x2){xa1[0], xa1[1]}, (f32x2){xb1[0], xb1[1]}, c1, c2), p3 = swiglu_pk((f32x2){xa1[2], xa1[3]}, (f32x2){xb1[2], xb1[3]}, c1, c2);
                    w[mo].x = cvt_pk4_fp8(p0.x, p0.y, p1.x, p1.y); w[mo].y = cvt_pk4_fp8(p2.x, p2.y, p3.x, p3.y); }
                const auto sx = __builtin_amdgcn_permlane32_swap(w[0].x, w[1].x, false, false), sy = __builtin_amdgcn_permlane32_swap(w[0].y, w[1].y, false, false);
                u32x4 o; o.x = sx[0]; o.y = sy[0]; o.z = sx[1]; o.w = sy[1];
                *(u32x4*)(blk + (lo + (ai * HALF + mp * 32) * 128)) = o; }
    }
};
struct EpiSwiGLUi8 {
    static constexpr bool PERM2 = true;
    unsigned char* O; int ldc; const float* rs; const unsigned* cmax;
    __device__ __forceinline__ void operator()(const f32x4 (&acc)[2][2][4][2], const Unit& u, int wr, int wc, int fr, int fq) const {
        const int rowl = u.om * BM + wr * 64 + fr, rows = rowl + ((fq >> 1) ? 16 : 0), col0 = u.on * HALF + wc * 32 + 16 * (fq & 1);
        const int brow0 = u.on * BM + wc * 32 + 16 * (fq & 1) + 8 * (fq >> 1);
        f32x4 ca[2], cb[2];
#pragma unroll
        for (int n = 0; n < 2; ++n) { const u32x4 wa = *(const u32x4*)(cmax + brow0 + 4 * n), wb = *(const u32x4*)(cmax + brow0 + HALF + 4 * n);
#pragma unroll
            for (int j = 0; j < 4; ++j) { ca[n][j] = __uint_as_float(wa[j]) * (1.0f / 127.0f); cb[n][j] = __uint_as_float(wb[j]) * (1.0f / 127.0f); } }
#pragma unroll
        for (int ai = 0; ai < 2; ++ai)
#pragma unroll
            for (int mp = 0; mp < 2; ++mp) {
                u32x2 w[2];
#pragma unroll
                for (int mo = 0; mo < 2; ++mo) { const int m = 2 * mp + mo; const float rsv = rs[rowl + ai * HALF + m * 16];
                    f32x2 o[2][2];
#pragma unroll
                    for (int n = 0; n < 2; ++n)
#pragma unroll
                        for (int jp = 0; jp < 2; ++jp) {
                            const f32x2 x = {(float)__float_as_int(acc[ai][0][m][n][2 * jp]), (float)__float_as_int(acc[ai][0][m][n][2 * jp + 1])}, y = {(float)__float_as_int(acc[ai][1][m][n][2 * jp]), (float)__float_as_int(acc[ai][1][m][n][2 * jp + 1])};
                            const f32x2 sa = (f32x2){ca[n][2 * jp], ca[n][2 * jp + 1]} * rsv, sb = (f32x2){cb[n][2 * jp], cb[n][2 * jp + 1]} * rsv;
                            o[n][jp] = swiglu_pk(x, y, sa * (-1.44269504089f), sa * sb); }
                    w[mo].x = cvt_pk4_fp8(o[0][0].x, o[0][0].y, o[0][1].x, o[0][1].y); w[mo].y = cvt_pk4_fp8(o[1][0].x, o[1][0].y, o[1][1].x, o[1][1].y); }
                const auto sx = __builtin_amdgcn_permlane32_swap(w[0].x, w[1].x, false, false), sy = __builtin_amdgcn_permlane32_swap(w[0].y, w[1].y, false, false);
                u32x4 o16; o16.x = sx[0]; o16.y = sy[0]; o16.z = sx[1]; o16.w = sy[1];
                *(u32x4*)(O + (size_t)(rows + ai * HALF + mp * 32) * ldc + col0) = o16; }
    }
};
struct EpiConvIni8 {
    static constexpr bool PERM2 = false;
    bf16_t* BG; bf16_t* U; const float* rs; const unsigned* cmax;
    __device__ __forceinline__ void operator()(const f32x4 (&acc)[2][2][4][2], const Unit& u, int wr, int wc, int fr, int fq) const {
        const int row0 = u.om * BM + wr * 64 + fr, brow0 = u.on * BM + wc * 32 + 8 * fq;
        f32x4 cs[2][2];
#pragma unroll
        for (int bj = 0; bj < 2; ++bj)
#pragma unroll
            for (int n = 0; n < 2; ++n) { const u32x4 w = *(const u32x4*)(cmax + brow0 + bj * HALF + 4 * n);
#pragma unroll
                for (int j = 0; j < 4; ++j) cs[bj][n][j] = __uint_as_float(w[j]) * (1.0f / 127.0f); }
#pragma unroll
        for (int ai = 0; ai < 2; ++ai)
#pragma unroll
            for (int m = 0; m < 4; ++m) { const int r = row0 + ai * HALF + m * 16; const float rsv = rs[r];
                f32x4 v[2][2];
#pragma unroll
                for (int bj = 0; bj < 2; ++bj)
#pragma unroll
                    for (int n = 0; n < 2; ++n)
#pragma unroll
                        for (int j = 0; j < 4; ++j) v[bj][n][j] = (float)__float_as_int(acc[ai][bj][m][n][j]) * (rsv * cs[bj][n][j]);
                if (u.on < 4) { bf16_t* rowp = BG + (size_t)r * D + u.on * BM + wc * 32 + 8 * fq;
#pragma unroll
                    for (int bj = 0; bj < 2; ++bj) { u32x4 w; w.x = cvt_pk_bf16(v[bj][0][0], v[bj][0][1]); w.y = cvt_pk_bf16(v[bj][0][2], v[bj][0][3]); w.z = cvt_pk_bf16(v[bj][1][0], v[bj][1][1]); w.w = cvt_pk_bf16(v[bj][1][2], v[bj][1][3]);
                        *(u32x4*)(rowp + bj * HALF) = w; } }
                else { bf16_t* rowp = U + (size_t)r * D + (u.on - 4) * HALF + wc * 32 + 8 * fq;
                    const f32x4 o0 = v[0][0] * v[1][0], o1 = v[0][1] * v[1][1];
                    u32x4 w; w.x = cvt_pk_bf16(o0[0], o0[1]); w.y = cvt_pk_bf16(o0[2], o0[3]); w.z = cvt_pk_bf16(o1[0], o1[1]); w.w = cvt_pk_bf16(o1[2], o1[3]);
                    *(u32x4*)rowp = w; } }
    }
};
struct EpiConvIn {
    static constexpr bool PERM2 = false;
    bf16_t* BG; bf16_t* U;
    __device__ __forceinline__ void operator()(const f32x4 (&acc)[2][2][4][2], const Unit& u, int wr, int wc, int fr, int fq) const {
        if (u.on < 4) { EpiPlain e{BG, D, 1.0f}; e(acc, u, wr, wc, fr, fq); return; }
        const int row0 = u.om * BM + wr * 64 + fr, col0 = (u.on - 4) * HALF + wc * 32 + 8 * fq;
#pragma unroll
        for (int ai = 0; ai < 2; ++ai)
#pragma unroll
            for (int m = 0; m < 4; ++m) { bf16_t* rowp = U + (size_t)(row0 + ai * HALF + m * 16) * D + col0;
                const f32x4 o0 = acc[ai][0][m][0] * acc[ai][1][m][0], o1 = acc[ai][0][m][1] * acc[ai][1][m][1];
                u32x4 w; w.x = cvt_pk_bf16(o0[0], o0[1]); w.y = cvt_pk_bf16(o0[2], o0[3]); w.z = cvt_pk_bf16(o1[0], o1[1]); w.w = cvt_pk_bf16(o1[2], o1[3]);
                *(u32x4*)rowp = w; }
    }
};
struct EpiQKV {
    static constexpr bool PERM2 = false;
    bf16_t *q, *k, *v, *kc, *vc; const float* rope; float ds;
    __device__ __forceinline__ void operator()(const f32x4 (&acc)[2][2][4][2], const Unit& u, int wr, int wc, int fr, int fq) const {
        const bool ctx = u.om >= 128;
        const int row0 = u.om * BM + wr * 64 + fr - (ctx ? T : 0);
        const int ct0 = wc * 32 + 8 * fq;
        bf16_t* base; int ldc, colb; float sc = ds; bool rot = false;
        if (u.on < 4) { base = q; ldc = D; colb = u.on * BM; sc = ds * 0.125f * 1.44269504089f; rot = true; }
        else if (u.on == 4) { base = ctx ? kc : k; ldc = 256; colb = 0; rot = !ctx; }
        else { base = ctx ? vc : v; ldc = 256; colb = 0; }
#pragma unroll
        for (int ai = 0; ai < 2; ++ai)
#pragma unroll
            for (int m = 0; m < 4; ++m) {
                const int r = row0 + ai * HALF + m * 16;
                bf16_t* rowp = base + (size_t)r * ldc + colb + ct0;
                f32x4 cs0 = {1.f, 0.f, 1.f, 0.f}, cs1 = {1.f, 0.f, 1.f, 0.f};
                if (rot) { const int s = r & (SEQ - 1); const int pos = (wc & 1) ? (s & 63) : (s >> 6);
                    const f32x4* tp = (const f32x4*)(rope + (size_t)(pos * 16 + 4 * fq) * 2); cs0 = tp[0]; cs1 = tp[1]; }
#pragma unroll
                for (int bj = 0; bj < 2; ++bj) { const f32x4 v0 = acc[ai][bj][m][0], v1 = acc[ai][bj][m][1];
                    f32x4 o0, o1;
                    o0[0] = v0[0] * cs0[0] - v1[0] * cs0[1]; o1[0] = v1[0] * cs0[0] + v0[0] * cs0[1];
                    o0[1] = v0[1] * cs0[2] - v1[1] * cs0[3]; o1[1] = v1[1] * cs0[2] + v0[1] * cs0[3];
                    o0[2] = v0[2] * cs1[0] - v1[2] * cs1[1]; o1[2] = v1[2] * cs1[0] + v0[2] * cs1[1];
                    o0[3] = v0[3] * cs1[2] - v1[3] * cs1[3]; o1[3] = v1[3] * cs1[2] + v0[3] * cs1[3];
                    o0 = o0 * sc; o1 = o1 * sc;
                    u32x4 w; w.x = cvt_pk_bf16(o0[0], o0[1]); w.y = cvt_pk_bf16(o0[2], o0[3]); w.z = cvt_pk_bf16(o1[0], o1[1]); w.w = cvt_pk_bf16(o1[2], o1[3]);
                    *(u32x4*)(rowp + bj * HALF) = w; } }
    }
};

template <int MODE  , class Epi, class Sched, bool BLK = false>
__device__ __forceinline__ void gemm_phase(LAS unsigned char* lds, const Gemm g, const Sched& S, const Epi& E) {
    int tid_ = threadIdx.x; if constexpr (Sched::HAS_KO) asm volatile("" : "+v"(tid_));
    const int tid = tid_, wid = __builtin_amdgcn_readfirstlane(tid >> 6), lane = tid & 63, wr = wid >> 2, wc = wid & 3, fr = lane & 15, fq = lane >> 4;
    constexpr bool FP8 = (MODE == 1);
    const int K = MODE ? g.K / 2 : g.K, nt = K / BK;
    unsigned voffA[2], voffB[2];
#pragma unroll
    for (int i = 0; i < 2; ++i) { int R, C; stage_rc(tid * 16 + i * 8192, R, C); const int Rb = (R & ~31) + (Epi::PERM2 ? perm32b(R & 31) : perm32(R & 31));
        voffA[i] = (unsigned)(R * (BLK ? BK : K) + C) * 2u; voffB[i] = (unsigned)(Rb * (BLK ? BK : K) + C) * 2u; }
    const unsigned kstep = BLK ? (unsigned)(BM * BK * 2) : (unsigned)(BK * 2);
    const unsigned hstep = BLK ? (unsigned)(HALF * BK * 2) : (unsigned)HALF * K * 2;
    const unsigned tstep = BLK ? (unsigned)(g.ntt ? g.ntt : nt) * (unsigned)(BM * BK * 2) : 2 * hstep;
    const __amdgpu_buffer_rsrc_t rsA = __builtin_amdgcn_make_buffer_rsrc((void*)g.A, (short)0, 0x7fffffff, 0x00020000);
    const __amdgpu_buffer_rsrc_t rsB = __builtin_amdgcn_make_buffer_rsrc((void*)g.Bt, (short)0, 0x7fffffff, 0x00020000);
    const unsigned ldsw = (unsigned)wid * 1024u;
    const int aoff = lds_byte(wr * 64 + fr, fq * 8), boff = lds_byte(wc * 32 + fr, fq * 8);
#define PG8_SA(b, h) (((b) * 2 + (h)) * HTB)
#define PG8_SB(b, h) ((4 + (b) * 2 + (h)) * HTB)
#define PG8_STAGE(bufoff, gbase, voff) do { _Pragma("unroll") for (int _i = 0; _i < 2; ++_i) \
        __builtin_amdgcn_raw_ptr_buffer_load_lds(PG8_RS_##voff, (LAS void*)(lds + (bufoff) + ldsw + _i * 8192), 16, (voff)[_i], (gbase), 0, 0); } while (0)
#define PG8_RS_voffA rsA
#define PG8_RS_voffB rsB
#define PG8_LDA(dst, b, h) do { _Pragma("unroll") for (int m = 0; m < 4; ++m) _Pragma("unroll") for (int k = 0; k < 2; ++k) dst[m][k] = *(const LAS bf16x8*)(lds + PG8_SA(b, h) + aoff + m * 2048 + k * 1024); } while (0)
#define PG8_LDB(dst, b, h) do { _Pragma("unroll") for (int n = 0; n < 2; ++n) _Pragma("unroll") for (int k = 0; k < 2; ++k) dst[n][k] = *(const LAS bf16x8*)(lds + PG8_SB(b, h) + boff + n * 2048 + k * 1024); } while (0)
#define PG8_MMA(ai, bj, At, Bt) do { __builtin_amdgcn_s_setprio(1); _Pragma("unroll") for (int m = 0; m < 4; ++m) _Pragma("unroll") for (int n = 0; n < 2; ++n) { \
        if constexpr (FP8) { const v8i a8 = __builtin_shufflevector(__builtin_bit_cast(v4i, At[m][0]), __builtin_bit_cast(v4i, At[m][1]), 0, 1, 2, 3, 4, 5, 6, 7); \
            const v8i b8 = __builtin_shufflevector(__builtin_bit_cast(v4i, Bt[n][0]), __builtin_bit_cast(v4i, Bt[n][1]), 0, 1, 2, 3, 4, 5, 6, 7); \
            acc[ai][bj][m][n] = __builtin_amdgcn_mfma_scale_f32_16x16x128_f8f6f4(b8, a8, acc[ai][bj][m][n], 0, 0, 0, 0x7F7F7F7F, 0, 0x7F7F7F7F); } \
        else if constexpr (MODE == 2) { _Pragma("unroll") for (int k = 0; k < 2; ++k) acc[ai][bj][m][n] = __builtin_bit_cast(f32x4, __builtin_amdgcn_mfma_i32_16x16x64_i8(__builtin_bit_cast(v4i, Bt[n][k]), __builtin_bit_cast(v4i, At[m][k]), __builtin_bit_cast(v4i, acc[ai][bj][m][n]), 0, 0, 0)); } \
        else { _Pragma("unroll") for (int k = 0; k < 2; ++k) acc[ai][bj][m][n] = __builtin_amdgcn_mfma_f32_16x16x32_bf16(Bt[n][k], At[m][k], acc[ai][bj][m][n], 0, 0, 0); } } \
        __builtin_amdgcn_s_setprio(0); } while (0)
#define PG8_WAIT_V(n) asm volatile("s_waitcnt vmcnt(" #n ")" ::: "memory")
#define PG8_WAIT_L(n) asm volatile("s_waitcnt lgkmcnt(" #n ")" ::: "memory")
#define PG8_BAR __builtin_amdgcn_s_barrier()
#define PG8_SCHED __builtin_amdgcn_sched_barrier(0)
    Unit cur, nxt; int ui = 0;
    if (!S.next(0, cur)) return;
    f32x4 acc[2][2][4][2];
#pragma unroll
    for (int a = 0; a < 2; ++a)
#pragma unroll
        for (int b = 0; b < 2; ++b)
#pragma unroll
            for (int m = 0; m < 4; ++m)
#pragma unroll
                for (int n = 0; n < 2; ++n) acc[a][b][m][n] = (f32x4){0.f, 0.f, 0.f, 0.f};
    bf16x8 At[4][2], B0[2][2], B1[2][2];
    unsigned cA = __builtin_amdgcn_readfirstlane((unsigned)cur.am * tstep + (Sched::HAS_KO ? (unsigned)cur.ko * kstep : 0u)), cB = __builtin_amdgcn_readfirstlane((unsigned)cur.bn * tstep + (Sched::HAS_KO ? (unsigned)cur.ko * kstep : 0u));
    PG8_STAGE(PG8_SB(0, 0), cB, voffB); PG8_STAGE(PG8_SB(0, 1), cB + hstep, voffB); PG8_STAGE(PG8_SA(0, 0), cA, voffA); PG8_STAGE(PG8_SA(0, 1), cA + hstep, voffA);
    if (wr == 1) PG8_BAR;
    PG8_WAIT_V(2); PG8_BAR;
    PG8_STAGE(PG8_SB(1, 0), cB + kstep, voffB); PG8_STAGE(PG8_SA(1, 0), cA + kstep, voffA); PG8_STAGE(PG8_SB(1, 1), cB + hstep + kstep, voffB);
    PG8_WAIT_V(6); PG8_BAR;
    for (;;) {
        const bool has_next = S.next(ui + 1, nxt);
        const unsigned nA = __builtin_amdgcn_readfirstlane(has_next ? (unsigned)nxt.am * tstep + (Sched::HAS_KO ? (unsigned)nxt.ko * kstep : 0u) : cA), nB = __builtin_amdgcn_readfirstlane(has_next ? (unsigned)nxt.bn * tstep + (Sched::HAS_KO ? (unsigned)nxt.ko * kstep : 0u) : cB);
#pragma unroll 1
        for (int t = 0; t < nt; t += 2) {
            const bool last = (t == nt - 2);
            const unsigned a1 = __builtin_amdgcn_readfirstlane(cA + (unsigned)(t + 1) * kstep);
            const unsigned a2 = __builtin_amdgcn_readfirstlane(last ? nA : cA + (unsigned)(t + 2) * kstep), b2 = __builtin_amdgcn_readfirstlane(last ? nB : cB + (unsigned)(t + 2) * kstep);
            const unsigned a3 = a2 + kstep, b3 = b2 + kstep;
            PG8_LDB(B0, 0, 0); PG8_LDB(B1, 0, 1); PG8_SCHED; PG8_LDA(At, 0, 0); PG8_STAGE(PG8_SA(1, 1), a1 + hstep, voffA);
            PG8_WAIT_V(8); PG8_WAIT_L(0); PG8_BAR; PG8_MMA(0, 0, At, B0); PG8_MMA(0, 1, At, B1); PG8_BAR; PG8_SCHED;
            PG8_LDA(At, 0, 1); PG8_STAGE(PG8_SB(0, 0), b2, voffB); PG8_STAGE(PG8_SB(0, 1), b2 + hstep, voffB); PG8_STAGE(PG8_SA(0, 0), a2, voffA);
            PG8_WAIT_V(8); PG8_WAIT_L(0); PG8_BAR; PG8_MMA(1, 0, At, B0); PG8_MMA(1, 1, At, B1); PG8_BAR; PG8_SCHED;
            PG8_LDB(B0, 1, 0); PG8_LDB(B1, 1, 1); PG8_SCHED; PG8_LDA(At, 1, 0); PG8_STAGE(PG8_SA(0, 1), a2 + hstep, voffA);
            PG8_WAIT_V(8); PG8_WAIT_L(0); PG8_BAR; PG8_MMA(0, 0, At, B0); PG8_MMA(0, 1, At, B1); PG8_BAR; PG8_SCHED;
            PG8_LDA(At, 1, 1); PG8_STAGE(PG8_SB(1, 0), b3, voffB); PG8_STAGE(PG8_SB(1, 1), b3 + hstep, voffB); PG8_STAGE(PG8_SA(1, 0), a3, voffA);
            PG8_WAIT_V(8); PG8_WAIT_L(0); PG8_BAR; PG8_MMA(1, 0, At, B0); PG8_MMA(1, 1, At, B1); PG8_BAR; PG8_SCHED;
        }
        if (wr == 0) PG8_BAR;
        { int fr_ = fr, fq_ = fq; asm volatile("" : "+v"(fr_), "+v"(fq_));
          E(acc, cur, wr, wc, fr_, fq_); }
        if (!has_next) break;
#pragma unroll
        for (int a = 0; a < 2; ++a)
#pragma unroll
            for (int b = 0; b < 2; ++b)
#pragma unroll
                for (int m = 0; m < 4; ++m)
#pragma unroll
                    for (int n = 0; n < 2; ++n) acc[a][b][m][n] = (f32x4){0.f, 0.f, 0.f, 0.f};
        cur = nxt; cA = nA; cB = nB; ++ui;
        if (wr == 1) PG8_BAR;
    }
    PG8_WAIT_V(0);
    PG8_BAR;
#undef PG8_SA
#undef PG8_SB
#undef PG8_STAGE
#undef PG8_RS_voffA
#undef PG8_RS_voffB
#undef PG8_LDA
#undef PG8_LDB
#undef PG8_MMA
#undef PG8_WAIT_V
#undef PG8_WAIT_L
#undef PG8_BAR
#undef PG8_SCHED
}
}

struct Args {
    const float* in[21];
    float* out; unsigned char* ws;
    int ph_lo, ph_hi;
};
enum { I_X = 0, I_C, I_CTX, I_CCTX, I_WMOD, I_BMOD, I_LNG, I_LNB, I_WQKV, I_WO, I_SINK, I_CWIN, I_CW, I_CWOUT, I_W1, I_W3, I_W2, I_ROUTER, I_MW1, I_MW3, I_MW2 };

__device__ __forceinline__ void p0_load_tile(const float* src, int ld, int col0, int k0, LAS float* scr, int lane) {
    f32x4 v[8]; const int c4 = (lane & 7) * 4, kr = lane >> 3;
#pragma unroll
    for (int i = 0; i < 8; ++i) v[i] = *(const f32x4*)(src + (size_t)(k0 + kr + 8 * i) * ld + col0 + c4);
#pragma unroll
    for (int i = 0; i < 8; ++i) { LAS float* p = scr + (kr + 8 * i) * 33 + c4; p[0] = v[i][0]; p[1] = v[i][1]; p[2] = v[i][2]; p[3] = v[i][3]; }
    LDS_WAIT(); asm volatile("" ::: "memory");
}
__device__ __forceinline__ void p0_transpose_item(const float* src, int ld, int col0, int k0, bf16_t* dst, int K, bool permq, LAS float* scr, int lane) {
    p0_load_tile(src, ld, col0, k0, scr, lane);
    const int c = lane & 7;
#pragma unroll
    for (int j = 0; j < 4; ++j) { const int n = (lane >> 3) + 8 * j;
        const int ns = permq ? (16 * ((n >> 2) & 1) + 4 * (n >> 3) + (n & 3)) : n;
        const LAS float* s = scr + (8 * c) * 33 + ns;
        u32x4 o; o.x = cvt_pk_bf16(s[0 * 33], s[1 * 33]); o.y = cvt_pk_bf16(s[2 * 33], s[3 * 33]); o.z = cvt_pk_bf16(s[4 * 33], s[5 * 33]); o.w = cvt_pk_bf16(s[6 * 33], s[7 * 33]);
        *(u32x4*)(dst + (size_t)n * K + 8 * c) = o; }
    LDS_WAIT(); asm volatile("" ::: "memory");
}
__device__ __forceinline__ void p0_absmax_item(const float* src, int ld, int col0, int k0, unsigned* cmax, int lane) {
    f32x4 v[8]; const int c4 = (lane & 7) * 4, kr = lane >> 3;
#pragma unroll
    for (int i = 0; i < 8; ++i) v[i] = *(const f32x4*)(src + (size_t)(k0 + kr + 8 * i) * ld + col0 + c4);
    f32x4 mx = {0.f, 0.f, 0.f, 0.f};
#pragma unroll
    for (int i = 0; i < 8; ++i)
#pragma unroll
        for (int j = 0; j < 4; ++j) mx[j] = fmaxf(mx[j], fabsf(v[i][j]));
#pragma unroll
    for (int j = 0; j < 4; ++j) { float m = mx[j]; m = fmaxf(m, __shfl_xor(m, 8)); m = fmaxf(m, __shfl_xor(m, 16)); m = fmaxf(m, __shfl_xor(m, 32)); mx[j] = m; }
    if (lane < 8) {
#pragma unroll
        for (int j = 0; j < 4; ++j) atomicMax(cmax + c4 + j, __float_as_uint(mx[j])); }
}
__device__ __forceinline__ void p0_transpose_item_i8(const float* src, int ld, int col0, int k0, unsigned char* dst, int K, const unsigned* cmax, LAS float* scr, int lane) {
    p0_load_tile(src, ld, col0, k0, scr, lane);
    const int c = lane & 7;
#pragma unroll
    for (int j = 0; j < 4; ++j) { const int n = (lane >> 3) + 8 * j;
        const float am = __uint_as_float(cmax[n]); const float sc = am > 0.f ? 127.0f / am : 0.f;
        const LAS float* s = scr + (8 * c) * 33 + n;
        u32x2 o; o.x = pk4_i8(s[0 * 33] * sc, s[1 * 33] * sc, s[2 * 33] * sc, s[3 * 33] * sc); o.y = pk4_i8(s[4 * 33] * sc, s[5 * 33] * sc, s[6 * 33] * sc, s[7 * 33] * sc);
        *(u32x2*)(dst + (size_t)n * K + 8 * c) = o; }
    LDS_WAIT(); asm volatile("" ::: "memory");
}
__device__ __forceinline__ void p0_transpose_item8(const float* src, int ld, int col0, int k0, unsigned char* dst, int K, float sc, LAS float* scr, int lane, bool permq = false) {
    p0_load_tile(src, ld, col0, k0, scr, lane);
    const int c = lane & 7;
#pragma unroll
    for (int j = 0; j < 4; ++j) { const int n = (lane >> 3) + 8 * j;
        const int ns = permq ? (16 * ((n >> 2) & 1) + 4 * (n >> 3) + (n & 3)) : n;
        const LAS float* s = scr + (8 * c) * 33 + ns;
        u32x2 o; o.x = cvt_pk4_fp8(s[0 * 33] * sc, s[1 * 33] * sc, s[2 * 33] * sc, s[3 * 33] * sc); o.y = cvt_pk4_fp8(s[4 * 33] * sc, s[5 * 33] * sc, s[6 * 33] * sc, s[7 * 33] * sc);
        *(u32x2*)(dst + (size_t)n * K + 8 * c) = o; }
    LDS_WAIT(); asm volatile("" ::: "memory");
}
__device__ __forceinline__ void p0_prologue(const Args& a, LAS unsigned char* lds, int G, int bx) {
    const int tid = threadIdx.x, lane = tid & 63, wave = __builtin_amdgcn_readfirstlane(tid >> 6);
    unsigned char* ws = a.ws;
    for (int task = bx; task < 192; task += G) {
        const int layer = task / 96, col0 = 64 * (task % 96);
        LAS float* sl = (LAS float*)lds;
        LAS float* part = (LAS float*)(lds + 17 * 1024 * 4);
        { f32x4 cv[9];
#pragma unroll
          for (int i = 0; i < 9; ++i) { const int q = tid + 512 * i; if (q < 4352) cv[i] = (q >> 8) < 16 ? *(const f32x4*)(a.in[I_C] + 4 * q) : *(const f32x4*)(a.in[I_CCTX] + 4 * (q & 255)); }
#pragma unroll
          for (int i = 0; i < 9; ++i) { const int q = tid + 512 * i; if (q < 4352) { f32x4 o;
#pragma unroll
                  for (int j = 0; j < 4; ++j) o[j] = cv[i][j] / (1.0f + __expf(-cv[i][j]));
                  *(LAS f32x4*)(sl + 4 * q) = o; } } }
        __syncthreads();
        const int cg = tid & 15, ks = tid >> 4;
        f32x4 acc[17];
#pragma unroll
        for (int b = 0; b < 17; ++b) acc[b] = (f32x4){0.f, 0.f, 0.f, 0.f};
        const float* wp = a.in[I_WMOD] + (size_t)layer * 1024 * 6144 + col0 + 4 * cg;
#pragma unroll 1
        for (int k16 = 0; k16 < 2; ++k16) { f32x4 w[16];
#pragma unroll
            for (int u = 0; u < 16; ++u) w[u] = *(const f32x4*)(wp + (size_t)(ks + 32 * (16 * k16 + u)) * 6144);
#pragma unroll
            for (int u = 0; u < 16; ++u) { const int kk = ks + 32 * (16 * k16 + u);
#pragma unroll
                for (int b = 0; b < 17; ++b) acc[b] += w[u] * sl[b * 1024 + kk]; } }
#pragma unroll
        for (int b = 0; b < 17; ++b)
#pragma unroll
            for (int j = 0; j < 4; ++j) { float v = acc[b][j]; v += __shfl_xor(v, 16); v += __shfl_xor(v, 32); acc[b][j] = v; }
        if (lane < 16) {
#pragma unroll
            for (int b = 0; b < 17; ++b) *(LAS f32x4*)(part + (wave * 17 + b) * 64 + 4 * cg) = acc[b]; }
        __syncthreads();
        float* modv = (float*)(ws + WS_MODV) + (size_t)layer * 17 * 6144;
        for (int idx = tid; idx < 17 * 64; idx += 512) { const int b = idx >> 6, cc = idx & 63; float s = a.in[I_BMOD][layer * 6144 + col0 + cc];
#pragma unroll
            for (int w = 0; w < 8; ++w) s += part[(w * 17 + b) * 64 + cc];
            modv[(size_t)b * 6144 + col0 + cc] = s; }
        __syncthreads();
    }
    if (bx == G - 1) { for (int idx = tid; idx < 1024; idx += 512) { const int pos = idx >> 4, j = idx & 15;
            const float inv = exp2f(-(float)j * (13.287712379549449f / 16.0f));
            const float ang = (float)pos * inv; float s, c; sincosf(ang, &s, &c);
            float* rp = (float*)(ws + WS_ROPE) + idx * 2; rp[0] = c; rp[1] = s; } }
    LAS float* scr = (LAS float*)(lds + wave * 16384);
    const int gw = bx * NWAVES + wave, NGW = G * NWAVES;
    constexpr int I1 = 16 * 48, I2 = 16 * 32, I3 = 16 * 176, I4 = 44 * 32, I5 = 16 * 96, I6 = 16 * 32, I7 = NE * 16 * 224, I8 = NE * 56 * 32;
    constexpr int NITEMS = I1 + I2 + I3 + I4 + I5 + I6;
    (void)I7; (void)I8;
    __syncthreads();
    for (int it = gw; it < NITEMS; it += NGW) {
        int r = it;
        if (r < I1) { const int kb = r / 48, nb = r % 48; p0_transpose_item8(a.in[I_WQKV], NQKV, 32 * nb, 64 * kb, (unsigned char*)(ws + WS_WQKV) + (size_t)(32 * nb) * D + 64 * kb, D, 128.0f, scr, lane, nb < 40); continue; } r -= I1;
        if (r < I2) { const int kb = r / 32, nb = r % 32; p0_transpose_item8(a.in[I_WO], D, 32 * nb, 64 * kb, (unsigned char*)(ws + WS_WO) + (size_t)(32 * nb) * D + 64 * kb, D, 256.0f, scr, lane); continue; } r -= I2;
        if (r < I3) { const int kb = r / 176, nb = r % 176, t = nb >> 3, sub = nb & 7;
            p0_absmax_item(sub < 4 ? a.in[I_W1] : a.in[I_W3], DFF, 128 * t + 32 * (sub & 3), 64 * kb, (unsigned*)(ws + WS_CMAX13) + 32 * nb, lane); continue; } r -= I3;
        if (r < I4) { const int kb = r / 32, nb = r % 32; p0_transpose_item8(a.in[I_W2], D, 32 * nb, 64 * kb, (unsigned char*)(ws + WS_W2) + (size_t)(32 * nb) * DFF + 64 * kb, DFF, 512.0f, scr, lane); continue; } r -= I4;
        if (r < I5) { const int kb = r / 96, nb = r % 96; int col0;
            if (nb < 32) col0 = 32 * nb; else { const int n2 = nb - 32, t = n2 >> 3, sub = n2 & 7; col0 = (sub < 4 ? 1024 : 2048) + 128 * t + 32 * (sub & 3); }
            p0_absmax_item(a.in[I_CWIN], 3 * D, col0, 64 * kb, (unsigned*)(ws + WS_CMAXCIN) + 32 * nb, lane); continue; } r -= I5;
        { const int kb = r / 32, nb = r % 32; p0_transpose_item(a.in[I_CWOUT], D, 32 * nb, 64 * kb, (bf16_t*)(ws + WS_WCOUT) + (size_t)(32 * nb) * D + 64 * kb, D, false, scr, lane); }
    }
}
constexpr int MOE_I7 = NE * 16 * 224, MOE_I8 = NE * 56 * 32, MOE_ITEMS = MOE_I7 + MOE_I8;
__device__ __forceinline__ bool moe_item(const Args& a, LAS unsigned char* lds, int wave, int lane) {
    LAS unsigned* q = (LAS unsigned*)(lds + MISC_OFF);
    unsigned itu = 0u; if (lane == 0) itu = __hip_atomic_fetch_add(q, 1u, __ATOMIC_RELAXED, __HIP_MEMORY_SCOPE_WORKGROUP);
    int r = (int)__builtin_amdgcn_readfirstlane(itu) * (int)gridDim.x + (int)blockIdx.x;
    if (r >= MOE_ITEMS) return false;
    LAS float* scr = (LAS float*)(lds + wave * 16384);
    unsigned char* ws = a.ws;
    if (r < MOE_I7) { const int e = r / 3584, r2 = r % 3584, kb = r2 / 224, nb = r2 % 224, t = nb >> 3, sub = nb & 7;
        p0_transpose_item8((sub < 4 ? a.in[I_MW1] : a.in[I_MW3]) + (size_t)e * D * DFE, DFE, 128 * t + 32 * (sub & 3), 64 * kb, (unsigned char*)(ws + WS_WM13) + ((size_t)e * 2 * DFE + 32 * nb) * D + 64 * kb, D, 128.0f, scr, lane); }
    else { r -= MOE_I7; const int e = r / 1792, r2 = r % 1792, kb = r2 / 32, nb = r2 % 32;
        p0_transpose_item8(a.in[I_MW2] + (size_t)e * DFE * D, D, 32 * nb, 64 * kb, (unsigned char*)(ws + WS_WM2) + (((size_t)(e * 4 + (nb >> 3)) * (DFE / 128) + (kb >> 1)) * 256 + 32 * (nb & 7)) * 128 + 64 * (kb & 1), 128, 512.0f, scr, lane); }
    return true;
}

__device__ __forceinline__ void p1_modulate(const Args& a, LAS unsigned char* lds, int G, int bx) {
    const int tid = threadIdx.x, lane = tid & 63, wave = __builtin_amdgcn_readfirstlane(tid >> 6);
    { LAS float* scr = (LAS float*)(lds + wave * 16384);
      for (int r = bx * NWAVES + wave; r < 16 * 176; r += G * NWAVES) { const int kb = r / 176, nb = r % 176, t = nb >> 3, sub = nb & 7;
          p0_transpose_item_i8(sub < 4 ? a.in[I_W1] : a.in[I_W3], DFF, 128 * t + 32 * (sub & 3), 64 * kb, (unsigned char*)(a.ws + WS_W13) + (size_t)(32 * nb) * D + 64 * kb, D, (const unsigned*)(a.ws + WS_CMAX13) + 32 * nb, scr, lane); }
      for (int r = (G - 1 - bx) * NWAVES + wave; r < 16 * 96; r += G * NWAVES) { const int kb = r / 96, nb = r % 96; int col0;
          if (nb < 32) col0 = 32 * nb; else { const int n2 = nb - 32, t = n2 >> 3, sub = n2 & 7; col0 = (sub < 4 ? 1024 : 2048) + 128 * t + 32 * (sub & 3); }
          p0_transpose_item_i8(a.in[I_CWIN], 3 * D, col0, 64 * kb, (unsigned char*)(a.ws + WS_WCIN) + (size_t)(32 * nb) * D + 64 * kb, D, (const unsigned*)(a.ws + WS_CMAXCIN) + 32 * nb, scr, lane); } }
    const float* modv = (const float*)(a.ws + WS_MODV);
    unsigned char* H = (unsigned char*)(a.ws + WS_H);
    constexpr int NRW = 3;
    for (int row0 = bx * NWAVES + wave; row0 < HROWS; row0 += NRW * G * NWAVES) {
        f32x4 xv[NRW][4], shv[NRW][4], scv[NRW][4];
#pragma unroll
        for (int q = 0; q < NRW; ++q) { const int row = row0 + q * G * NWAVES;
            if (row < HROWS) { const bool cx = row >= T;
                const float* xr = cx ? a.in[I_CTX] + (size_t)(row - T) * D : a.in[I_X] + (size_t)row * D;
                const float* mv = modv + (size_t)(cx ? 16 : (row >> 11)) * 6144;
#pragma unroll
                for (int j = 0; j < 4; ++j) { const int col = 4 * lane + 256 * j; xv[q][j] = *(const f32x4*)(xr + col); shv[q][j] = *(const f32x4*)(mv + col); scv[q][j] = *(const f32x4*)(mv + 1024 + col); } } }
#pragma unroll
        for (int q = 0; q < NRW; ++q) { const int row = row0 + q * G * NWAVES;
            if (row < HROWS) {
#pragma unroll
                for (int j = 0; j < 4; ++j) { const int col = 4 * lane + 256 * j;
                    const f32x4 hv = xv[q][j] * (scv[q][j] + 1.0f) + shv[q][j];
                    *(unsigned*)(H + (size_t)row * D + col) = cvt_pk4_fp8(hv[0], hv[1], hv[2], hv[3]); } } }
    }
}

typedef short s16x4 __attribute__((ext_vector_type(4)));
constexpr int AT_STR = 144;
template <int NCH>
__device__ __forceinline__ void attn_load(u32x4 (&kr)[5], u32x4 (&vr)[5], const bf16_t* Kg, const bf16_t* Vg, long row0, int lo, int hi, int kh, int tid) {
#pragma unroll
    for (int i = 0; i < NCH; ++i) { const int ch = tid + 512 * i, key = ch >> 3, part = ch & 7;
        kr[i] = (u32x4){0u, 0u, 0u, 0u}; vr[i] = (u32x4){0u, 0u, 0u, 0u};
        if (key >= lo && key < hi) { const size_t off = (size_t)(row0 + key) * 256 + kh * 64 + part * 8; kr[i] = *(const u32x4*)(Kg + off); vr[i] = *(const u32x4*)(Vg + off); } }
}
template <int NCH>
__device__ __forceinline__ void attn_store(LAS unsigned char* Ks, LAS unsigned char* Vs, const u32x4 (&kr)[5], const u32x4 (&vr)[5], int tid) {
#pragma unroll
    for (int i = 0; i < NCH; ++i) { const int ch = tid + 512 * i, key = ch >> 3, part = ch & 7;
        *(LAS u32x4*)(Ks + key * AT_STR + part * 16) = kr[i]; *(LAS u32x4*)(Vs + key * AT_STR + part * 16) = vr[i]; }
}
template <int NBLK, bool MASK>
__device__ __forceinline__ void attn_step(const LAS unsigned char* Ks, const LAS unsigned char* Vs, int kb0, const bf16x8 (&Qf)[4], f32x16 (&O)[2], float& m, float& l, int n, int h, int vtoff, int qi, int klo, int khi) {
    bf16x8 kf[NBLK][4];
#pragma unroll
    for (int b = 0; b < NBLK; ++b)
#pragma unroll
        for (int c = 0; c < 4; ++c) kf[b][c] = *(const LAS bf16x8*)(Ks + (32 * (kb0 + b) + n) * AT_STR + (16 * c + 8 * h) * 2);
    __builtin_amdgcn_sched_barrier(0);
    f32x16 s[NBLK];
#pragma unroll
    for (int b = 0; b < NBLK; ++b) {
#pragma unroll
        for (int i = 0; i < 16; ++i) s[b][i] = 0.f;
#pragma unroll
        for (int c = 0; c < 4; ++c) s[b] = __builtin_amdgcn_mfma_f32_32x32x16_bf16(kf[b][c], Qf[c], s[b], 0, 0, 0);
    }
    s16x4 vlo[2][2], vhi[2][2];
#pragma unroll
    for (int sp = 0; sp < 2; ++sp)
#pragma unroll
        for (int db = 0; db < 2; ++db) {
            const LAS unsigned char* vp = Vs + vtoff + (32 * kb0 + 16 * sp) * AT_STR + 64 * db;
            vlo[sp][db] = __builtin_amdgcn_ds_read_tr16_b64_v4i16((LAS s16x4*)vp); vhi[sp][db] = __builtin_amdgcn_ds_read_tr16_b64_v4i16((LAS s16x4*)(vp + 8 * AT_STR)); }
    __builtin_amdgcn_sched_barrier(0);
    if (MASK) {
#pragma unroll
        for (int b = 0; b < NBLK; ++b)
#pragma unroll
            for (int i = 0; i < 16; ++i) { const int key = 32 * (kb0 + b) + 8 * (i >> 2) + 4 * h + (i & 3);
                const bool ok = (key >= klo) && (key < khi) && (key >= qi - 128) && (key <= qi + 128);
                s[b][i] = ok ? s[b][i] : -1e30f; }
    }
    float mx = s[0][0];
#pragma unroll
    for (int b = 0; b < NBLK; ++b)
#pragma unroll
        for (int i = 0; i < 16; ++i) mx = fmaxf(mx, s[b][i]);
    mx = fmaxf(mx, __shfl_xor(mx, 32));
    const float mn = fmaxf(m, mx);
    const float alpha = __builtin_amdgcn_exp2f(m - mn);
    m = mn;
    float ps = 0.f;
#pragma unroll
    for (int b = 0; b < NBLK; ++b)
#pragma unroll
        for (int i = 0; i < 16; ++i) { s[b][i] = __builtin_amdgcn_exp2f(s[b][i] - mn); ps += s[b][i]; }
    l = l * alpha + ps;
#pragma unroll
    for (int i = 0; i < 16; ++i) { O[0][i] *= alpha; O[1][i] *= alpha; }
#pragma unroll
    for (int b = 0; b < NBLK; ++b) {
        bf16x8 pf[2];
#pragma unroll
        for (int sp = 0; sp < 2; ++sp) { u32x4 w; w.x = cvt_pk_bf16(s[b][8 * sp + 0], s[b][8 * sp + 1]); w.y = cvt_pk_bf16(s[b][8 * sp + 2], s[b][8 * sp + 3]); w.z = cvt_pk_bf16(s[b][8 * sp + 4], s[b][8 * sp + 5]); w.w = cvt_pk_bf16(s[b][8 * sp + 6], s[b][8 * sp + 7]); pf[sp] = __builtin_bit_cast(bf16x8, w); }
        bf16x8 vf[2][2];
#pragma unroll
        for (int sp = 0; sp < 2; ++sp)
#pragma unroll
            for (int db = 0; db < 2; ++db) vf[sp][db] = __builtin_shufflevector(vlo[sp][db], vhi[sp][db], 0, 1, 2, 3, 4, 5, 6, 7);
        if (b + 1 < NBLK) {
#pragma unroll
            for (int sp = 0; sp < 2; ++sp)
#pragma unroll
                for (int db = 0; db < 2; ++db) {
                    const LAS unsigned char* vp = Vs + vtoff + (32 * (kb0 + b + 1) + 16 * sp) * AT_STR + 64 * db;
                    vlo[sp][db] = __builtin_amdgcn_ds_read_tr16_b64_v4i16((LAS s16x4*)vp); vhi[sp][db] = __builtin_amdgcn_ds_read_tr16_b64_v4i16((LAS s16x4*)(vp + 8 * AT_STR)); }
        }
#pragma unroll
        for (int sp = 0; sp < 2; ++sp)
#pragma unroll
            for (int db = 0; db < 2; ++db) O[db] = __builtin_amdgcn_mfma_f32_32x32x16_bf16(vf[sp][db], pf[sp], O[db], 0, 0, 0);
    }
}
#define AT_BAR() do { asm volatile("s_waitcnt lgkmcnt(0)" ::: "memory"); __builtin_amdgcn_s_barrier(); asm volatile("" ::: "memory"); } while (0)
__device__ __forceinline__ void p3_attention(const Args& a, LAS unsigned char* lds, int G, int bx) {
    const int tid = threadIdx.x, lane = tid & 63, wid = __builtin_amdgcn_readfirstlane(tid >> 6), n = lane & 31, h = lane >> 5, g = wid >> 1, qs = wid & 1;
    LAS unsigned char* Ks = lds; LAS unsigned char* Vs = lds + 320 * AT_STR;
    const int vtoff = (4 * h + ((lane & 15) >> 2)) * AT_STR + (16 * ((lane >> 4) & 1) + 4 * (lane & 3)) * 2;
    const bf16_t* Q = (const bf16_t*)(a.ws + WS_Q); const bf16_t* Kb = (const bf16_t*)(a.ws + WS_K); const bf16_t* Vb = (const bf16_t*)(a.ws + WS_V);
    const bf16_t* KC = (const bf16_t*)(a.ws + WS_KC); const bf16_t* VC = (const bf16_t*)(a.ws + WS_VC); unsigned char* AO = (unsigned char*)(a.ws + WS_AO);
    u32x4 kr[5], vr[5];
    if (bx < 2048) { const int kh0 = (bx >> 5) & 3, b0 = bx >> 7; attn_load<4>(kr, vr, KC, VC, (long)b0 * CTX, 0, 256, kh0, tid); }
    for (int unit = bx; unit < 2048; unit += G) {
        const int qb = unit & 31, kh = (unit >> 5) & 3, b = unit >> 7, q0 = 64 * qb;
        const int head = 4 * kh + g;
        const size_t qrow = (size_t)b * SEQ + q0 + 32 * qs + n;
        bf16x8 Qf[4];
#pragma unroll
        for (int c = 0; c < 4; ++c) Qf[c] = *(const bf16x8*)(Q + qrow * D + head * 64 + 16 * c + 8 * h);
        f32x16 O[2];
#pragma unroll
        for (int i = 0; i < 16; ++i) { O[0][i] = 0.f; O[1][i] = 0.f; }
        float m = a.in[I_SINK][head] * 1.44269504089f, l = (h == 0) ? 1.0f : 0.0f;
        const int klo = (q0 - 128 < 0) ? (128 - q0) : 0, khi = (q0 + 192 > SEQ) ? (SEQ - (q0 - 128)) : 320;
        const bool edge = (klo != 0) || (khi != 320);
        AT_BAR();
        attn_store<4>(Ks, Vs, kr, vr, tid);
        attn_load<5>(kr, vr, Kb, Vb, (long)b * SEQ + q0 - 128, klo, khi, kh, tid);
        AT_BAR();
#pragma unroll 1
        for (int kb = 0; kb < 8; kb += 2) attn_step<2, false>(Ks, Vs, kb, Qf, O, m, l, n, h, vtoff, 0, 0, 0);
        AT_BAR();
        attn_store<5>(Ks, Vs, kr, vr, tid);
        { const int nu = unit + G; if (nu < 2048) { const int kh1 = (nu >> 5) & 3, b1 = nu >> 7; attn_load<4>(kr, vr, KC, VC, (long)b1 * CTX, 0, 256, kh1, tid); } }
        AT_BAR();
        const int qi = 128 + 32 * qs + n;
        attn_step<2, true>(Ks, Vs, qs, Qf, O, m, l, n, h, vtoff, qi, klo, khi);
        if (edge) {
#pragma unroll 1
            for (int kb = qs + 2; kb < qs + 8; kb += 2) attn_step<2, true>(Ks, Vs, kb, Qf, O, m, l, n, h, vtoff, qi, klo, khi);
        } else {
#pragma unroll 1
            for (int kb = qs + 2; kb < qs + 8; kb += 2) attn_step<2, false>(Ks, Vs, kb, Qf, O, m, l, n, h, vtoff, qi, klo, khi);
        }
        attn_step<1, true>(Ks, Vs, qs + 8, Qf, O, m, l, n, h, vtoff, qi, klo, khi);
        l += __shfl_xor(l, 32);
        const float inv = 16.0f / l;
        unsigned char* op = AO + qrow * D + head * 64;
        unsigned wx[4], wy[4];
#pragma unroll
        for (int i4 = 0; i4 < 4; ++i4) {
            const unsigned w0 = cvt_pk4_fp8(O[0][4 * i4 + 0] * inv, O[0][4 * i4 + 1] * inv, O[0][4 * i4 + 2] * inv, O[0][4 * i4 + 3] * inv);
            const unsigned w1 = cvt_pk4_fp8(O[1][4 * i4 + 0] * inv, O[1][4 * i4 + 1] * inv, O[1][4 * i4 + 2] * inv, O[1][4 * i4 + 3] * inv);
            const auto sw = __builtin_amdgcn_permlane32_swap(w0, w1, false, false); wx[i4] = sw[0]; wy[i4] = sw[1]; }
        u32x4 lo, hi; lo.x = wx[0]; lo.y = wy[0]; lo.z = wx[1]; lo.w = wy[1]; hi.x = wx[2]; hi.y = wy[2]; hi.z = wx[3]; hi.w = wy[3];
        *(u32x4*)(op + 32 * h) = lo; *(u32x4*)(op + 32 * h + 16) = hi;
    }
}

__device__ __forceinline__ int tail_split(int nlo, int G) { return (nlo * 7 <= G) ? 7 : ((nlo * 2 <= G) ? 2 : 1); }
__device__ __forceinline__ void tail_reduce(const Args& a, int G, int bx, int np, int l0, int nlo, int spl) {
    const float* YP = (const float*)(a.ws + WS_HS8); bf16_t* Y = (bf16_t*)(a.ws + WS_Y);
    const int tid = threadIdx.x;
    for (int it = bx * 512 + tid; it < nlo * 16384; it += G * 512) {
        const int jt = it >> 14, r = (it >> 6) & 255, c4 = it & 63;
        int pm, pn; pg8::tile_of(l0 + jt, np, 4, pm, pn);
        const float* q = YP + ((size_t)jt * spl) * (256 * 256) + r * 256 + 4 * c4;
        f32x4 v[7];
#pragma unroll
        for (int sp = 0; sp < 7; ++sp) { v[sp] = (f32x4){0.f, 0.f, 0.f, 0.f}; if (sp < spl) v[sp] = *(const f32x4*)(q + (size_t)sp * (256 * 256)); }
        const f32x4 t = ((v[0] + v[1]) + (v[2] + v[3])) + ((v[4] + v[5]) + v[6]);
        u32x2 w; w.x = cvt_pk_bf16(t[0], t[1]); w.y = cvt_pk_bf16(t[2], t[3]);
        *(u32x2*)(Y + ((size_t)pm * 256 + r) * D + pn * 256 + 4 * c4) = w;
    }
}
template <int MODE, int HQ = 0  , bool XIN_BF = false, bool XOUT_BF = false>
__device__ __forceinline__ void ln_phase(const Args& a, LAS unsigned char* lds, int G, int bx, const float* xin, float* xout, const bf16_t* mix, const float* gate  ,
                                         const float* lng, const float* lnb, const float* scn, const float* shn  , bf16_t* hout, float gscale = 1.0f, float* rsout = nullptr) {
    const int tid = threadIdx.x, lane = tid & 63, wave = tid >> 6;
    LAS float* wr_t = (LAS float*)lds;
    LAS int* tokE = (LAS int*)(lds + 32768);
    LAS float* tokL = (LAS float*)(lds + 32768 + 2048);
    (void)tokL;
    if (MODE == 1) { for (int idx = tid; idx < 8 * 1024; idx += 512) { const int e = idx >> 10, d = idx & 1023; wr_t[idx] = a.in[I_ROUTER][d * 8 + e]; } __syncthreads(); }
    const int nvb = (MODE == 1) ? 256 : 0;
    for (int vb0 = bx; vb0 < 256; vb0 += G) {
        const int vb = (G == 256) ? ((vb0 & 7) * 32 + (vb0 >> 3)) : vb0;
        const int bb = (vb * 128) >> 11;
        f32x4 gtv[4], lgv[4], lbv[4], lcv[4], ldv[4];
#pragma unroll
        for (int j = 0; j < 4; ++j) { const int col = 4 * lane + 256 * j;
            gtv[j] = *(const f32x4*)(gate + (size_t)bb * 6144 + col) * gscale; lgv[j] = *(const f32x4*)(lng + col); lbv[j] = *(const f32x4*)(lnb + col);
            if (MODE != 2) { const f32x4 s1 = *(const f32x4*)(scn + (size_t)bb * 6144 + col) + 1.0f; lcv[j] = lgv[j] * s1; ldv[j] = lbv[j] * s1 + *(const f32x4*)(shn + (size_t)bb * 6144 + col); }
            else { lcv[j] = lgv[j]; ldv[j] = lbv[j]; } }
        for (int rr = 0; rr < 16; ++rr) {
            const int lt = wave * 16 + rr, row = vb * 128 + lt;
            f32x4 t[4]; float s = 0.f;
            float g0 = 0.f, g1 = 0.f; size_t p0 = 0, p1 = 0;
            if (MODE == 2) { const float2 gg = ((const float2*)(a.ws + WS_TOKG))[row]; const int2 pp = ((const int2*)(a.ws + WS_TOKP))[row]; g0 = gg.x; g1 = gg.y; p0 = (size_t)pp.x; p1 = (size_t)pp.y; }
#pragma unroll
            for (int j = 0; j < 4; ++j) { const int col = 4 * lane + 256 * j;
                f32x4 x; if (XIN_BF) { const u32x2 xw = *(const u32x2*)((const bf16_t*)xin + (size_t)row * D + col); x[0] = bf_lo(xw.x); x[1] = bf_hi(xw.x); x[2] = bf_lo(xw.y); x[3] = bf_hi(xw.y); }
                else x = *(const f32x4*)(xin + (size_t)row * D + col);
                f32x4 mf;
                if (MODE == 2) { const u32x2 y0 = *(const u32x2*)(mix + p0 * D + col), y1 = *(const u32x2*)(mix + p1 * D + col);
                    mf[0] = g0 * bf_lo(y0.x) + g1 * bf_lo(y1.x); mf[1] = g0 * bf_hi(y0.x) + g1 * bf_hi(y1.x); mf[2] = g0 * bf_lo(y0.y) + g1 * bf_lo(y1.y); mf[3] = g0 * bf_hi(y0.y) + g1 * bf_hi(y1.y); }
                else { const u32x2 mw = *(const u32x2*)(mix + (size_t)row * D + col); mf[0] = bf_lo(mw.x); mf[1] = bf_hi(mw.x); mf[2] = bf_lo(mw.y); mf[3] = bf_hi(mw.y); }
                t[j] = x * ALPHA + gtv[j] * mf; s += (t[j][0] + t[j][1]) + (t[j][2] + t[j][3]); }
            const float mean = wave_sum(s) * (1.0f / D); float s2 = 0.f;
#pragma unroll
            for (int j = 0; j < 4; ++j) { t[j] = t[j] - mean; s2 += (t[j][0] * t[j][0] + t[j][1] * t[j][1]) + (t[j][2] * t[j][2] + t[j][3] * t[j][3]); }
            const float rstd = 1.0f / sqrtf(wave_sum(s2) * (1.0f / D) + LN_EPS);
            float lg[8];
#pragma unroll
            for (int e = 0; e < 8; ++e) lg[e] = 0.f;
            f32x4 hq[4];
#pragma unroll
            for (int j = 0; j < 4; ++j) { const int col = 4 * lane + 256 * j;
                const f32x4 dn = t[j] * rstd; const f32x4 y = dn * lgv[j] + lbv[j];
                if (XOUT_BF) { u32x2 yw; yw.x = cvt_pk_bf16(y[0], y[1]); yw.y = cvt_pk_bf16(y[2], y[3]); *(u32x2*)((bf16_t*)xout + (size_t)row * D + col) = yw; }
                else *(f32x4*)(xout + (size_t)row * D + col) = y;
                if (MODE != 2) { const f32x4 hv = dn * lcv[j] + ldv[j];
                    hq[j] = hv;
                    if (MODE == 1 || HQ == 1) { *(unsigned*)((unsigned char*)hout + (size_t)row * D + col) = cvt_pk4_fp8(hv[0], hv[1], hv[2], hv[3]); }
                    else if (HQ == 0) { u32x2 w; w.x = cvt_pk_bf16(hv[0], hv[1]); w.y = cvt_pk_bf16(hv[2], hv[3]); *(u32x2*)(hout + (size_t)row * D + col) = w; }
                    if (MODE == 1) {
#pragma unroll
                        for (int e = 0; e < 8; ++e) { const f32x4 wv = *(const LAS f32x4*)(wr_t + e * 1024 + col); lg[e] += (hv[0] * wv[0] + hv[1] * wv[1]) + (hv[2] * wv[2] + hv[3] * wv[3]); } } } }
            if (MODE != 2 && HQ == 2) {
                float am = 0.f;
#pragma unroll
                for (int j = 0; j < 4; ++j) am = fmaxf(am, fmaxf(fmaxf(fabsf(hq[j][0]), fabsf(hq[j][1])), fmaxf(fabsf(hq[j][2]), fabsf(hq[j][3]))));
                am = wave_max(am);
                const float qs = am > 0.f ? 127.0f / am : 0.f;
#pragma unroll
                for (int j = 0; j < 4; ++j) *(unsigned*)((unsigned char*)hout + (size_t)row * D + 4 * lane + 256 * j) = pk4_i8(hq[j][0] * qs, hq[j][1] * qs, hq[j][2] * qs, hq[j][3] * qs);
                if (lane == 0) rsout[row] = am * (1.0f / 127.0f);
            }
            if (MODE == 1) {
#pragma unroll
                for (int e = 0; e < 8; ++e) lg[e] = wave_sum(lg[e]);
                int e0 = 0; float l0 = lg[0];
#pragma unroll
                for (int e = 1; e < 8; ++e) if (lg[e] > l0) { l0 = lg[e]; e0 = e; }
                int e1 = -1; float l1 = -3.0e38f;
#pragma unroll
                for (int e = 0; e < 8; ++e) if (e != e0 && lg[e] > l1) { l1 = lg[e]; e1 = e; }
                if (e1 < 0) { e1 = (e0 + 1) & 7; l1 = lg[e1]; }
                if (lane == 0) { tokE[lt * 2] = e0; tokE[lt * 2 + 1] = e1; const float ex = __expf(l1 - l0); const float gg0 = 1.0f / (1.0f + ex);
                    ((float2*)(a.ws + WS_TOKG))[row] = make_float2(gg0, ex * gg0); }
            }
        }
        if (MODE == 1) {
            __syncthreads();
            if (tid < 8) { int cnt = 0; for (int i = 0; i < 256; ++i) { if (tokE[i] == tid) { tokE[256 + i] = cnt; ++cnt; } } ((int*)(a.ws + WS_WGCNT))[vb * 8 + tid] = cnt; }
            __syncthreads();
            if (tid < 128) { int4 v; v.x = tokE[2 * tid]; v.y = tokE[2 * tid + 1]; v.z = tokE[256 + 2 * tid]; v.w = tokE[256 + 2 * tid + 1]; ((int4*)(a.ws + WS_TOKE))[vb * 128 + tid] = v; }
            __syncthreads();
        }
    }
    (void)nvb;
}

__device__ __forceinline__ void p10_conv(const Args& a, int G, int bx) {
    const int tid = threadIdx.x, lane = tid & 63, wave = tid >> 6;
    const bf16_t* BG = (const bf16_t*)(a.ws + WS_BG); const bf16_t* U = (const bf16_t*)(a.ws + WS_U); bf16_t* Z = (bf16_t*)(a.ws + WS_Z);
    const float* cw = a.in[I_CW];
    f32x4 w0[2][2], w1[2][2], w2[2][2];
#pragma unroll
    for (int j = 0; j < 2; ++j)
#pragma unroll
        for (int hf = 0; hf < 2; ++hf) { const int col = 8 * lane + 512 * j + 4 * hf;
            w0[j][hf] = *(const f32x4*)(cw + col); w1[j][hf] = *(const f32x4*)(cw + D + col); w2[j][hf] = *(const f32x4*)(cw + 2 * D + col); }
    const u32x4 zero = {0u, 0u, 0u, 0u};
    for (int vb0 = bx; vb0 < 256; vb0 += G) {
        const int vb = (G == 256) ? ((vb0 & 7) * 32 + (vb0 >> 3)) : vb0;
        const int r0 = vb * 128 + wave * 16;
        u32x4 um[2], uc[2], un[2];
#pragma unroll
        for (int j = 0; j < 2; ++j) { const int col = 8 * lane + 512 * j;
            um[j] = (r0 & (SEQ - 1)) > 0 ? *(const u32x4*)(U + (size_t)(r0 - 1) * D + col) : zero;
            uc[j] = *(const u32x4*)(U + (size_t)r0 * D + col); }
        for (int rr = 0; rr < 16; ++rr) { const int row = r0 + rr, sq = row & (SEQ - 1);
            u32x4 bg[2];
#pragma unroll
            for (int j = 0; j < 2; ++j) { const int col = 8 * lane + 512 * j;
                un[j] = sq < SEQ - 1 ? *(const u32x4*)(U + (size_t)(row + 1) * D + col) : zero;
                bg[j] = *(const u32x4*)(BG + (size_t)row * D + col); }
#pragma unroll
            for (int j = 0; j < 2; ++j) { const int col = 8 * lane + 512 * j; u32x4 o;
#pragma unroll
                for (int q = 0; q < 4; ++q) { const int hf = q >> 1, e = 2 * (q & 1);
                    const float y0 = w0[j][hf][e] * bf_lo(um[j][q]) + w1[j][hf][e] * bf_lo(uc[j][q]) + w2[j][hf][e] * bf_lo(un[j][q]);
                    const float y1 = w0[j][hf][e + 1] * bf_hi(um[j][q]) + w1[j][hf][e + 1] * bf_hi(uc[j][q]) + w2[j][hf][e + 1] * bf_hi(un[j][q]);
                    o[q] = cvt_pk_bf16(bf_lo(bg[j][q]) * y0, bf_hi(bg[j][q]) * y1); }
                *(u32x4*)(Z + (size_t)row * D + col) = o;
                um[j] = uc[j]; uc[j] = un[j]; }
        }
    }
}

__device__ __forceinline__ void p13_scatter(const Args& a, LAS unsigned char* lds, int G, int bx) {
    const int tid = threadIdx.x, lane = tid & 63, wave = tid >> 6;
    LAS int* tot = (LAS int*)lds;
    const int* wgcnt = (const int*)(a.ws + WS_WGCNT);
    for (int vb0 = bx; vb0 < 256; vb0 += G) {
        const int vb = (G == 256) ? ((vb0 & 7) * 32 + (vb0 >> 3)) : vb0;
        __syncthreads();
        if (tid < 8) { int t = 0, mine = 0; for (int w = 0; w < 256; ++w) { const int c = wgcnt[w * 8 + tid]; if (w == vb) mine = t; t += c; } tot[tid] = t; tot[8 + tid] = mine; }
        __syncthreads();
        if (tid == 0) { int p = 0; for (int e = 0; e < 8; ++e) { tot[16 + e] = p; p += (tot[e] + 255) & ~255; } tot[24] = p;
            if (vb == 0) { int* ps = (int*)(a.ws + WS_PSTART); for (int e = 0; e < 9; ++e) ps[e] = tot[16 + e]; } }
        __syncthreads();
        const unsigned char* src = (const unsigned char*)(a.ws + WS_H3F8); unsigned char* HS = (unsigned char*)(a.ws + WS_HS8);
        for (int rr = 0; rr < 16; ++rr) { const int row = vb * 128 + wave * 16 + rr;
            const int4 ti = ((const int4*)(a.ws + WS_TOKE))[row];
            const int pos0 = tot[16 + ti.x] + tot[8 + ti.x] + ti.z, pos1 = tot[16 + ti.y] + tot[8 + ti.y] + ti.w;
            if (lane == 0) ((int2*)(a.ws + WS_TOKP))[row] = make_int2(pos0, pos1);
            const u32x4 v0 = *(const u32x4*)(src + (size_t)row * D + 16 * lane);
            *(u32x4*)(HS + (size_t)pos0 * D + 16 * lane) = v0; *(u32x4*)(HS + (size_t)pos1 * D + 16 * lane) = v0; }
    }
}

constexpr int NPH = 17;
__global__ void __launch_bounds__(NWAVES * 64, 2) mk_fwd(Args args) {
    extern __shared__ __attribute__((aligned(16))) unsigned char lds_raw[];
    LAS unsigned char* lds = (LAS unsigned char*)lds_raw;
    volatile LAS unsigned* MISC = (volatile LAS unsigned*)(lds + MISC_OFF);
    const int tid = threadIdx.x, G = gridDim.x, bx = blockIdx.x;
    if (tid < 16) MISC[tid] = 0u;
    __syncthreads();
    unsigned char* ws = args.ws;
    const int lo = args.ph_lo, hi = args.ph_hi;
    XcdBarrier bar; bar.bar = (unsigned*)(ws + WS_CTL); bar.x = 0; bar.st = nullptr;
    if (hi - lo > 1) bar = xcd_barrier_post((unsigned*)(ws + WS_CTL), MISC + 8);
#define IN(k) (lo <= (k) && (k) < hi)
#define SEAM(k) do { if (IN(k) && IN((k) + 1)) { if ((k) < 12) { const bool lead_ = xcd_barrier_arrive(bar); if (!lead_) { (void)moe_item(args, lds, __builtin_amdgcn_readfirstlane((int)threadIdx.x >> 6), (int)__builtin_amdgcn_mbcnt_hi(~0u, __builtin_amdgcn_mbcnt_lo(~0u, 0u))); } xcd_barrier_wait(bar); } else xcd_barrier(bar); } } while (0)
    const float* modv0 = (const float*)(ws + WS_MODV); const float* modv1 = modv0 + 17 * 6144;
    bf16_t* H = (bf16_t*)(ws + WS_H); bf16_t* MIX = (bf16_t*)(ws + WS_MIX);

#ifndef ZERO_MASK
#define ZERO_MASK 0
#endif
#ifndef REP_MASK
#define REP_MASK 0u
#endif
#define PHASE(k, ...) do { if (IN(k)) { { __VA_ARGS__ } if ((REP_MASK >> (k)) & 1u) { xcd_barrier(bar); { __VA_ARGS__ } } } SEAM(k); } while (0)
#define MOE_ORDER(S, nn) pg8::MoeOrder S; S.lim = 1 << 30; { const int* ps = (const int*)(ws + WS_PSTART); \
        S.pe0 = __builtin_amdgcn_readfirstlane(ps[1]) >> 8; S.pe1 = __builtin_amdgcn_readfirstlane(ps[2]) >> 8; S.pe2 = __builtin_amdgcn_readfirstlane(ps[3]) >> 8; S.pe3 = __builtin_amdgcn_readfirstlane(ps[4]) >> 8; \
        S.pe4 = __builtin_amdgcn_readfirstlane(ps[5]) >> 8; S.pe5 = __builtin_amdgcn_readfirstlane(ps[6]) >> 8; S.pe6 = __builtin_amdgcn_readfirstlane(ps[7]) >> 8; \
        S.np = __builtin_amdgcn_readfirstlane(ps[8]) >> 8; S.nN = (nn); S.G = G; S.c = bx; }
    PHASE(0, p0_prologue(args, lds, G, bx););
    PHASE(1, p1_modulate(args, lds, G, bx););
    PHASE(2,
        pg8::Gemm g{H, (const bf16_t*)(ws + WS_WQKV), D}; pg8::QkvOrder S{G, bx};
        pg8::EpiQKV E{(bf16_t*)(ws + WS_Q), (bf16_t*)(ws + WS_K), (bf16_t*)(ws + WS_V), (bf16_t*)(ws + WS_KC), (bf16_t*)(ws + WS_VC), (const float*)(ws + WS_ROPE), 1.0f / 128.0f};
        pg8::gemm_phase<1>(lds, g, S, E););
    PHASE(3, p3_attention(args, lds, G, bx););
    PHASE(4,
        pg8::Gemm g{(const bf16_t*)(ws + WS_AO), (const bf16_t*)(ws + WS_WO), D}; pg8::StaticOrder S; S.init(T / 256, D / 256, G, bx);
        pg8::EpiPlain E{MIX, D, 1.0f / 4096.0f}; pg8::gemm_phase<1>(lds, g, S, E););
    PHASE(5, ln_phase<0, 2, false, true>(args, lds, G, bx, args.in[I_X], (float*)(ws + WS_XB), MIX, modv0 + 2048, args.in[I_LNG], args.in[I_LNB], modv0 + 4096, modv0 + 3072, H, (ZERO_MASK & 1) ? 0.f : 1.f, (float*)(ws + WS_RS1)););
    PHASE(6,
        pg8::Gemm g{H, (const bf16_t*)(ws + WS_W13), D}; pg8::StaticOrder S; S.init(T / 256, 2 * DFF / 256, G, bx);
        pg8::EpiSwiGLUi8 E{(unsigned char*)(ws + WS_ACT), DFF, (const float*)(ws + WS_RS1), (const unsigned*)(ws + WS_CMAX13)}; pg8::gemm_phase<2>(lds, g, S, E););
    PHASE(7,
        pg8::Gemm g{(const bf16_t*)(ws + WS_ACT), (const bf16_t*)(ws + WS_W2), DFF}; pg8::StaticOrder S; S.init(T / 256, D / 256, G, bx);
        pg8::EpiPlain E{MIX, D, 1.0f / 512.0f}; pg8::gemm_phase<1>(lds, g, S, E););
    PHASE(8, ln_phase<0, 2, true, true>(args, lds, G, bx, (const float*)(ws + WS_XB), (float*)(ws + WS_XB), MIX, modv0 + 5120, args.in[I_LNG] + D, args.in[I_LNB] + D, modv1 + 1024, modv1, H, (ZERO_MASK & 2) ? 0.f : 1.f, (float*)(ws + WS_RS2)););
    PHASE(9,
        pg8::Gemm g{H, (const bf16_t*)(ws + WS_WCIN), D}; pg8::StaticOrder S; S.init(T / 256, 3 * D / 256, G, bx);
        pg8::EpiConvIni8 E{(bf16_t*)(ws + WS_BG), (bf16_t*)(ws + WS_U), (const float*)(ws + WS_RS2), (const unsigned*)(ws + WS_CMAXCIN)}; pg8::gemm_phase<2>(lds, g, S, E););
    PHASE(10, p10_conv(args, G, bx););
    PHASE(11,
        pg8::Gemm g{(const bf16_t*)(ws + WS_Z), (const bf16_t*)(ws + WS_WCOUT), D}; pg8::StaticOrder S; S.init(T / 256, D / 256, G, bx);
        pg8::EpiPlain E{MIX, D, 1.0f}; pg8::gemm_phase<0>(lds, g, S, E););
    PHASE(12, ln_phase<1, false, true, false>(args, lds, G, bx, (const float*)(ws + WS_XB), args.out, MIX, modv1 + 2048, args.in[I_LNG] + 2 * D, args.in[I_LNB] + 2 * D, modv1 + 4096, modv1 + 3072, (bf16_t*)(ws + WS_H3F8), (ZERO_MASK & 4) ? 0.f : 1.f););
    PHASE(13, { const int wv_ = __builtin_amdgcn_readfirstlane((int)threadIdx.x >> 6); const int ln_ = (int)__builtin_amdgcn_mbcnt_hi(~0u, __builtin_amdgcn_mbcnt_lo(~0u, 0u)); while (moe_item(args, lds, wv_, ln_)) {} __syncthreads(); } p13_scatter(args, lds, G, bx););
    PHASE(14, MOE_ORDER(S, 28); pg8::Gemm g{(const bf16_t*)(ws + WS_HS8), (const bf16_t*)(ws + WS_WM13), D}; pg8::EpiSwiGLU8 E{(unsigned char*)(ws + WS_MACT8), DFE, 1.0f / 128.0f}; pg8::gemm_phase<1>(lds, g, S, E););
    PHASE(15,
        MOE_ORDER(S, 4); const int nun_ = S.np * 4, nfr_ = nun_ / G, nlo_ = nun_ - nfr_ * G; S.lim = nfr_ * G;
        pg8::Gemm g{(const bf16_t*)(ws + WS_MACT8), (const bf16_t*)(ws + WS_WM2), DFE, 0}; pg8::EpiPlain E{(bf16_t*)(ws + WS_Y), D, 1.0f / 512.0f}; pg8::gemm_phase<1, pg8::EpiPlain, pg8::MoeOrder, true>(lds, g, S, E);
        if (nlo_ > 0) { const int spl_ = tail_split(nlo_, G);
            pg8::PieceOrder SP; SP.np = S.np; SP.G = G; SP.c = bx; SP.l0 = nfr_ * G; SP.spl = spl_; SP.npc = nlo_ * spl_; SP.ktp = (DFE / 128) / spl_;
            SP.pe0 = S.pe0; SP.pe1 = S.pe1; SP.pe2 = S.pe2; SP.pe3 = S.pe3; SP.pe4 = S.pe4; SP.pe5 = S.pe5; SP.pe6 = S.pe6;
            pg8::Gemm gp{(const bf16_t*)(ws + WS_MACT8), (const bf16_t*)(ws + WS_WM2), DFE / spl_, DFE / 128}; pg8::EpiPartial EP{(float*)(ws + WS_HS8), 1.0f / 512.0f};
            pg8::gemm_phase<1, pg8::EpiPartial, pg8::PieceOrder, true>(lds, gp, SP, EP);
            xcd_barrier(bar); tail_reduce(args, G, bx, S.np, nfr_ * G, nlo_, spl_); });
    if (IN(16)) { ln_phase<2>(args, lds, G, bx, args.out, args.out, (const bf16_t*)(ws + WS_Y), modv1 + 5120, args.in[I_LNG] + 3 * D, args.in[I_LNB] + 3 * D, nullptr, nullptr, nullptr, (ZERO_MASK & 8) ? 0.f : 1.f); }
#undef IN
#undef SEAM
}

extern "C" void kernel_launch(void* const* d_in, const int* in_sizes, int n_in, void* d_out, int out_size, void* d_ws, size_t ws_size, hipStream_t stream) {
    static int grid = 0;
    if (grid == 0) {
        if (n_in != 21 || out_size != T * D || ws_size < WS_END) { fprintf(stderr, "kernel_launch: unexpected problem (n_in %d out %d ws %zu need %zu)\n", n_in, out_size, ws_size, (size_t)WS_END); grid = -1; return; }
        int dev = 0, cus = 0;
        if (hipGetDevice(&dev) != hipSuccess || hipDeviceGetAttribute(&cus, hipDeviceAttributeMultiprocessorCount, dev) != hipSuccess) { grid = -1; return; }
        if (hipFuncSetAttribute((const void*)mk_fwd, hipFuncAttributeMaxDynamicSharedMemorySize, LDS_BYTES) != hipSuccess) { grid = -1; return; }
        int per_cu = 0;
        (void)hipOccupancyMaxActiveBlocksPerMultiprocessor(&per_cu, (const void*)mk_fwd, NWAVES * 64, LDS_BYTES);
        (void)hipGetLastError();
        grid = cus > 256 ? 256 : cus;
    }
    if (grid < 0) return;
    (void)hipMemsetAsync((char*)d_ws + WS_CTL, 0, CTL_ZERO_BYTES, stream);
    Args a{};
    for (int i = 0; i < 21; ++i) a.in[i] = (const float*)d_in[i];
    a.out = (float*)d_out; a.ws = (unsigned char*)d_ws;
#if MK_ONE_LAUNCH
    a.ph_lo = 0; a.ph_hi = NPH;
    hipLaunchKernelGGL(mk_fwd, dim3(grid), dim3(NWAVES * 64), LDS_BYTES, stream, a);
#else
    for (int p = 0; p < NPH; ++p) { a.ph_lo = p; a.ph_hi = p + 1; hipLaunchKernelGGL(mk_fwd, dim3(grid), dim3(NWAVES * 64), LDS_BYTES, stream, a); }
#endif
}
```

```cpp
#include <hip/hip_runtime.h>
#include <cstdio>
#include <cstdint>

#ifndef MK_ONE_LAUNCH
#define MK_ONE_LAUNCH 1
#endif

#define LAS __attribute__((address_space(3)))
#define GAS __attribute__((address_space(1)))
typedef unsigned short bf16_t;
typedef short bf16x8 __attribute__((ext_vector_type(8)));
typedef float f32x4 __attribute__((ext_vector_type(4)));
typedef float f32x16 __attribute__((ext_vector_type(16)));
typedef unsigned u32x4 __attribute__((ext_vector_type(4)));
typedef unsigned u32x2 __attribute__((ext_vector_type(2)));
typedef int v8i __attribute__((ext_vector_type(8)));
typedef int v4i __attribute__((ext_vector_type(4)));

constexpr int NB = 16, SEQ = 2048, D = 1024, T = NB * SEQ, CTX = 256, TC = NB * CTX;
constexpr int NQKV = 1536, DFF = 2816, NE = 8, DFE = 3584;
constexpr int HROWS = T + TC;
constexpr float LN_EPS = 1e-5f;
constexpr float ALPHA = 1.41421356237309515f;
constexpr int MAXP = 264;
constexpr int NWAVES = 8;

constexpr size_t MiB = 1u << 20;
constexpr size_t WS_CTL = 0, CTL_ZERO_BYTES = 128 * 1024;
constexpr size_t WS_MOEQ = 60 * 1024;
constexpr size_t WS_CMAX13 = 64 * 1024;
constexpr size_t WS_CMAXCIN = WS_CMAX13 + 5632 * 4;
constexpr size_t WS_MODV = 1 * MiB;
constexpr size_t WS_ROPE = WS_MODV + 2 * 17 * 6144 * 4;
constexpr size_t WS_WGCNT = WS_ROPE + 64 * 16 * 2 * 4;
constexpr size_t WS_PSTART = WS_WGCNT + 256 * 8 * 4;
constexpr size_t WS_TOKE = 2 * MiB;
constexpr size_t WS_TOKG = WS_TOKE + (size_t)T * 16;
constexpr size_t WS_TOKP = WS_TOKG + (size_t)T * 8;
constexpr size_t WS_RS1 = 3 * MiB;
constexpr size_t WS_RS2 = WS_RS1 + (size_t)T * 4;
constexpr size_t WS_W = 4 * MiB;
constexpr size_t WS_WQKV = WS_W;
constexpr size_t WS_WO = WS_WQKV + (size_t)NQKV * D * 2;
constexpr size_t WS_W13 = WS_WO + (size_t)D * D * 2;
constexpr size_t WS_W2 = WS_W13 + (size_t)2 * DFF * D * 2;
constexpr size_t WS_WCIN = WS_W2 + (size_t)D * DFF * 2;
constexpr size_t WS_WCOUT = WS_WCIN + (size_t)3 * D * D * 2;
constexpr size_t WS_WM13 = WS_WCOUT + (size_t)D * D * 2;
constexpr size_t WS_WM2 = WS_WM13 + (size_t)NE * 2 * DFE * D;
constexpr size_t WS_WEND = WS_WM2 + (size_t)NE * D * DFE;
constexpr size_t WS_H = (WS_WEND + MiB - 1) / MiB * MiB;
constexpr size_t WS_MIX = WS_H + (size_t)HROWS * D * 2;
constexpr size_t WS_A = WS_MIX + (size_t)T * D * 2;
constexpr size_t WS_Q = WS_A, WS_K = WS_Q + (size_t)T * D * 2, WS_V = WS_K + (size_t)T * 256 * 2, WS_KC = WS_V + (size_t)T * 256 * 2, WS_VC = WS_KC + (size_t)TC * 256 * 2;
constexpr size_t WS_AO = WS_VC + (size_t)TC * 256 * 2;
constexpr size_t WS_ACT = WS_A;
constexpr size_t WS_BG = WS_A, WS_U = WS_BG + (size_t)T * D * 2, WS_Z = WS_U + (size_t)T * D * 2;
constexpr size_t WS_XB = WS_Z + (size_t)T * D * 2;
constexpr size_t WS_Y = WS_H;
constexpr size_t WS_HS8 = WS_A;
constexpr size_t WS_MACT8 = WS_HS8 + (size_t)MAXP * 256 * D;
constexpr size_t WS_H3F8 = WS_MACT8;
constexpr size_t WS_END = WS_MACT8 + (size_t)MAXP * 256 * DFE;
static_assert(WS_Y + (size_t)MAXP * 256 * D * 2 <= WS_A, "sorted y rows fit over h | mix");
static_assert(WS_AO + (size_t)T * D * 2 <= WS_END && WS_ACT + (size_t)T * DFF * 2 <= WS_END && WS_Z + (size_t)T * D * 2 <= WS_END, "map");
static_assert(WS_XB + (size_t)T * D * 2 <= WS_END, "map");
static_assert(WS_END <= 615000000ull, "workspace too large");

constexpr int RING_BYTES = 131072;
constexpr int MISC_OFF = RING_BYTES;
constexpr int LDS_BYTES = 147456;

#define DPPF(old, v, ctrl, rm) __builtin_bit_cast(float, __builtin_amdgcn_update_dpp(__builtin_bit_cast(int, (float)(old)), __builtin_bit_cast(int, (float)(v)), (ctrl), (rm), 0xF, false))
__device__ __forceinline__ unsigned cvt_pk_bf16(float lo, float hi) { unsigned r; asm volatile("v_cvt_pk_bf16_f32 %0, %1, %2" : "=v"(r) : "v"(lo), "v"(hi)); return r; }
__device__ __forceinline__ unsigned cvt_pk4_fp8(float a, float b, float c, float d) { int w = __builtin_amdgcn_cvt_pk_fp8_f32(a, b, 0, false); w = __builtin_amdgcn_cvt_pk_fp8_f32(c, d, w, true); return (unsigned)w; }
__device__ __forceinline__ unsigned pk4_i8(float a, float b, float c, float d) {
    const int ia = (int)__builtin_rintf(a), ib = (int)__builtin_rintf(b), ic = (int)__builtin_rintf(c), id = (int)__builtin_rintf(d);
    return (unsigned)(ia & 255) | ((unsigned)(ib & 255) << 8) | ((unsigned)(ic & 255) << 16) | ((unsigned)id << 24); }
__device__ __forceinline__ float wave_max(float v) {
    v = fmaxf(v, DPPF(v, v, 0xB1, 0xF)); v = fmaxf(v, DPPF(v, v, 0x4E, 0xF)); v = fmaxf(v, DPPF(v, v, 0x141, 0xF)); v = fmaxf(v, DPPF(v, v, 0x140, 0xF));
    v = fmaxf(v, DPPF(v, v, 0x142, 0xA)); v = fmaxf(v, DPPF(v, v, 0x143, 0xC));
    return __builtin_bit_cast(float, __builtin_amdgcn_readlane(__builtin_bit_cast(int, v), 63));
}
__device__ __forceinline__ float bf_lo(unsigned w) { return __uint_as_float(w << 16); }
__device__ __forceinline__ float bf_hi(unsigned w) { return __uint_as_float(w & 0xffff0000u); }
__device__ __forceinline__ float wave_sum(float v) {
    v += DPPF(0.f, v, 0xB1, 0xF); v += DPPF(0.f, v, 0x4E, 0xF); v += DPPF(0.f, v, 0x141, 0xF); v += DPPF(0.f, v, 0x140, 0xF);
    v += DPPF(0.f, v, 0x142, 0xA); v += DPPF(0.f, v, 0x143, 0xC);
    return __builtin_bit_cast(float, __builtin_amdgcn_readlane(__builtin_bit_cast(int, v), 63));
}
#define LDS_WAIT() asm volatile("s_waitcnt lgkmcnt(0)" ::: "memory")
#define VM_WAIT() asm volatile("s_waitcnt vmcnt(0)" ::: "memory")

#define XB_TMO      128
#define XB_XCNT(j)  (256  + 64 * (j))
#define XB_XSUB(j)  (1280 + 64 * (j))
#define XB_XGEN(j)  (2304 + 64 * (j))
#define XB_TOP      3328
#define XB_TOPGEN   3392
#define XCD_BAR_WORDS 3456
#define XB_SPIN_CAP (1u << 18)
__device__ __forceinline__ unsigned xb_ld(unsigned* p)              { return __hip_atomic_load(p, __ATOMIC_RELAXED, __HIP_MEMORY_SCOPE_AGENT); }
__device__ __forceinline__ unsigned xb_add(unsigned* p, unsigned v) { return __hip_atomic_fetch_add(p, v, __ATOMIC_RELAXED, __HIP_MEMORY_SCOPE_AGENT); }
__device__ __forceinline__ unsigned xb_xcc_id() { return (unsigned)__builtin_amdgcn_s_getreg((3 << 11) | 20) & 0xFu; }
#define XB_SPIN(cond, bar) do { unsigned _sp = 0; while (cond) { __builtin_amdgcn_s_sleep(1); \
    if ((++_sp & 255u) == 0u) { if (xb_ld(&(bar)[XB_TMO])) break; if (_sp > XB_SPIN_CAP) { atomicAdd(&(bar)[XB_TMO], 1u); break; } } } } while (0)
struct XcdBarrier { unsigned* bar; unsigned x; volatile LAS unsigned* st; };
__device__ __forceinline__ XcdBarrier xcd_barrier_post(unsigned* bar, volatile LAS unsigned* st) {
    XcdBarrier b; b.bar = bar; b.x = xb_xcc_id(); b.st = st;
    if (threadIdx.x == 0) (void)xb_add(&bar[XB_XCNT(b.x)], 1u);
    return b;
}
__device__ __forceinline__ void xcd_barrier_complete(unsigned* bar, unsigned x, unsigned& nloc, unsigned& nx) {
    const unsigned G = gridDim.x * gridDim.y * gridDim.z;
    unsigned sum, cnt, mine, sp = 0u;
    for (;;) {
        sum = 0u; cnt = 0u; mine = 0u;
#pragma unroll
        for (unsigned j = 0; j < 16; ++j) { const unsigned c = xb_ld(&bar[XB_XCNT(j)]); sum += c; cnt += (c > 0u) ? 1u : 0u; mine = (j == x) ? c : mine; }
        if (sum == G) break;
        __builtin_amdgcn_s_sleep(1);
        if ((++sp & 255u) == 0u) { if (xb_ld(&bar[XB_TMO])) break; if (sp > XB_SPIN_CAP) { atomicAdd(&bar[XB_TMO], 1u); break; } }
    }
    nloc = mine > 0u ? mine : 1u; nx = cnt > 0u ? cnt : 1u;
}
__device__ __forceinline__ void xcd_barrier(const XcdBarrier& b) {
    asm volatile("s_waitcnt vmcnt(0)" ::: "memory");
    __syncthreads();
    if (threadIdx.x == 0) {
        unsigned* bar = b.bar;
        __builtin_amdgcn_s_waitcnt(0);
        unsigned nloc = b.st[0], nx = b.st[1];
        if (nloc == 0u) { xcd_barrier_complete(bar, b.x, nloc, nx); b.st[0] = nloc; b.st[1] = nx; }
        const unsigned old = xb_add(&bar[XB_XSUB(b.x)], 1u);
        const unsigned gen = old / nloc;
        if (old + 1u == (gen + 1u) * nloc) {
            __builtin_amdgcn_fence(__ATOMIC_RELEASE, "agent");
            asm volatile("s_waitcnt vmcnt(0)" ::: "memory");
            const unsigned og = xb_add(&bar[XB_TOP], 1u);
            const unsigned tg = og / nx;
            if (og + 1u == (tg + 1u) * nx) xb_add(&bar[XB_TOPGEN], 1u);
            else XB_SPIN(xb_ld(&bar[XB_TOPGEN]) == tg, bar);
            __builtin_amdgcn_fence(__ATOMIC_ACQUIRE, "agent");
            xb_add(&bar[XB_XGEN(b.x)], 1u);
            asm volatile("s_waitcnt vmcnt(0)" ::: "memory");
        } else {
            XB_SPIN(xb_ld(&bar[XB_XGEN(b.x)]) == gen, bar);
            __builtin_amdgcn_fence(__ATOMIC_ACQUIRE, "agent");
            asm volatile("s_waitcnt vmcnt(0)" ::: "memory");
        }
    }
    __syncthreads();
}

__device__ __forceinline__ bool xcd_barrier_arrive(const XcdBarrier& b) {
    asm volatile("s_waitcnt vmcnt(0)" ::: "memory");
    __syncthreads();
    if (threadIdx.x == 0) {
        unsigned* bar = b.bar;
        __builtin_amdgcn_s_waitcnt(0);
        unsigned nloc = b.st[0], nx = b.st[1];
        if (nloc == 0u) { xcd_barrier_complete(bar, b.x, nloc, nx); b.st[0] = nloc; b.st[1] = nx; }
        const unsigned old = xb_add(&bar[XB_XSUB(b.x)], 1u);
        const unsigned gen = old / nloc;
        unsigned role = 0u, tg = 0u;
        if (old + 1u == (gen + 1u) * nloc) {
            __builtin_amdgcn_fence(__ATOMIC_RELEASE, "agent");
            asm volatile("s_waitcnt vmcnt(0)" ::: "memory");
            const unsigned og = xb_add(&bar[XB_TOP], 1u);
            tg = og / nx; role = 1u;
            if (og + 1u == (tg + 1u) * nx) { xb_add(&bar[XB_TOPGEN], 1u); role = 2u; }
        }
        b.st[2] = gen; b.st[3] = tg; b.st[4] = role;
    }
    __syncthreads();
    return b.st[4] != 0u;
}
__device__ __forceinline__ void xcd_barrier_wait(const XcdBarrier& b) {
    if (threadIdx.x == 0) {
        unsigned* bar = b.bar;
        const unsigned gen = b.st[2], tg = b.st[3], role = b.st[4];
        if (role != 0u) {
            if (role == 1u) XB_SPIN(xb_ld(&bar[XB_TOPGEN]) == tg, bar);
            __builtin_amdgcn_fence(__ATOMIC_ACQUIRE, "agent");
            xb_add(&bar[XB_XGEN(b.x)], 1u);
            asm volatile("s_waitcnt vmcnt(0)" ::: "memory");
        } else {
            XB_SPIN(xb_ld(&bar[XB_XGEN(b.x)]) == gen, bar);
            __builtin_amdgcn_fence(__ATOMIC_ACQUIRE, "agent");
            asm volatile("s_waitcnt vmcnt(0)" ::: "memory");
        }
    }
    __syncthreads();
}

namespace pg8 {
constexpr int BM = 256, BK = 64, HALF = 128, HTB = HALF * BK * 2, STAGE_BYTES = 8 * HTB, NXCD = 8, WGM = 8;
__host__ __device__ __forceinline__ int lds_byte(int r, int c) { const int st = (r >> 4) * 2 + (c >> 5), rr = r & 15, cc = c & 31, ob = rr * 64 + cc * 2; return st * 1024 + (ob ^ (((ob >> 9) & 1) << 5)); }
__host__ __device__ __forceinline__ void stage_rc(int b, int& R, int& C) { const int st = b / 1024, sb = b % 1024, swz = sb ^ (((sb >> 9) & 1) << 5); R = (st >> 1) * 16 + swz / 64; C = (st & 1) * 32 + (swz % 64) / 2; }
__host__ __device__ __forceinline__ int perm32(int rho) { const int n = rho >> 4, i = rho & 15; return 8 * (i >> 2) + 4 * n + (i & 3); }

__host__ __device__ __forceinline__ int perm32b(int rho) { const int n = rho >> 4, i = rho & 15, f = i >> 2; return 16 * (f & 1) + 8 * (f >> 1) + 4 * n + (i & 3); }
struct Unit { int am, bn, om, on; };
struct Gemm { const bf16_t* A; const bf16_t* Bt; int K; };

__device__ __forceinline__ void tile_of(int L, int nM, int nN, int& pm, int& pn) {
    const int nwg = nM * nN; int wgid = L;
    { const int q = nwg / NXCD, r = nwg % NXCD, xcd = wgid % NXCD, off = wgid / NXCD; wgid = (xcd < r ? xcd * (q + 1) : r * (q + 1) + (xcd - r) * q) + off; }
    const int nig = WGM * nN, gid = wgid / nig, fm = gid * WGM, gsz = (nM - fm) < WGM ? (nM - fm) : WGM;
    pm = fm + ((wgid % nig) % gsz); pn = (wgid % nig) / gsz;
}
struct StaticOrder {
    int nM, nN, G, c;
    __device__ __forceinline__ void init(int nM_, int nN_, int G_, int c_) { nM = nM_; nN = nN_; G = G_; c = c_; }
    __device__ __forceinline__ bool next(int i, Unit& u) const {
        const int L = i * G + c; if (L >= nM * nN) return false;
        int pm, pn; tile_of(L, nM, nN, pm, pn); u.am = pm; u.om = pm; u.bn = pn; u.on = pn; return true;
    }
};
struct QkvOrder {
    int G, c;
    __device__ __forceinline__ bool next(int i, Unit& u) const {
        const int L = i * G + c; if (L >= 800) return false;
        int pm, pn;
        if (L < 768) tile_of(L, 128, 6, pm, pn); else { const int j = L - 768; pm = 128 + (j >> 1); pn = 4 + (j & 1); }
        u.am = pm; u.om = pm; u.bn = pn; u.on = pn; return true;
    }
};
struct MoeOrder {
    int np, nN, G, c; int pe0, pe1, pe2, pe3, pe4, pe5, pe6;
    __device__ __forceinline__ bool next(int i, Unit& u) const {
        const int L = i * G + c; if (L >= np * nN) return false;
        int pm, pn; tile_of(L, np, nN, pm, pn);
        const int e = (pm >= pe0) + (pm >= pe1) + (pm >= pe2) + (pm >= pe3) + (pm >= pe4) + (pm >= pe5) + (pm >= pe6);
        u.bn = e * nN + pn; u.on = pn; u.am = pm; u.om = pm;
        return true;
    }
};

struct EpiPlain {
    static constexpr bool PERM2 = false;
    bf16_t* O; int ldc; float sc;
    __device__ __forceinline__ void operator()(const f32x4 (&acc)[2][2][4][2], const Unit& u, int wr, int wc, int fr, int fq) const {
        const int row0 = u.om * BM + wr * 64 + fr, col0 = u.on * BM + wc * 32 + 8 * fq;
#pragma unroll
        for (int ai = 0; ai < 2; ++ai)
#pragma unroll
            for (int m = 0; m < 4; ++m) { bf16_t* rowp = O + (size_t)(row0 + ai * HALF + m * 16) * ldc + col0;
#pragma unroll
                for (int bj = 0; bj < 2; ++bj) { const f32x4 v0 = acc[ai][bj][m][0] * sc, v1 = acc[ai][bj][m][1] * sc;
                    u32x4 w; w.x = cvt_pk_bf16(v0[0], v0[1]); w.y = cvt_pk_bf16(v0[2], v0[3]); w.z = cvt_pk_bf16(v1[0], v1[1]); w.w = cvt_pk_bf16(v1[2], v1[3]);
                    *(u32x4*)(rowp + bj * HALF) = w; } }
    }
};
template <int WS, int AS>
struct EpiPlain8 {
    static constexpr bool PERM2 = false;
    static constexpr int WSCALE = WS, ASCALE = AS;
    bf16_t* O; int ldc;
    __device__ __forceinline__ void operator()(const f32x4 (&acc)[2][2][4][2], const Unit& u, int wr, int wc, int fr, int fq) const {
        const int row0 = u.om * BM + wr * 64 + fr, col0 = u.on * BM + wc * 32 + 8 * fq;
#pragma unroll
        for (int ai = 0; ai < 2; ++ai)
#pragma unroll
            for (int m = 0; m < 4; ++m) { bf16_t* rowp = O + (size_t)(row0 + ai * HALF + m * 16) * ldc + col0;
#pragma unroll
                for (int bj = 0; bj < 2; ++bj) { const f32x4 v0 = acc[ai][bj][m][0], v1 = acc[ai][bj][m][1];
                    u32x4 w; w.x = cvt_pk_bf16(v0[0], v0[1]); w.y = cvt_pk_bf16(v0[2], v0[3]); w.z = cvt_pk_bf16(v1[0], v1[1]); w.w = cvt_pk_bf16(v1[2], v1[3]);
                    *(u32x4*)(rowp + bj * HALF) = w; } }
    }
};
__device__ __forceinline__ float silu_f(float a) { return a * __builtin_amdgcn_rcpf(1.0f + __builtin_amdgcn_exp2f(-1.44269504089f * a)); }
typedef float f32x2 __attribute__((ext_vector_type(2)));
__device__ __forceinline__ f32x2 swiglu_pk(f32x2 x, f32x2 y, f32x2 c1, f32x2 c2) {
    const f32x2 m1 = x * c1; f32x2 e; e.x = __builtin_amdgcn_exp2f(m1.x); e.y = __builtin_amdgcn_exp2f(m1.y);
    const f32x2 d = e + 1.0f; f32x2 r; r.x = __builtin_amdgcn_rcpf(d.x); r.y = __builtin_amdgcn_rcpf(d.y);
    return ((x * y) * r) * c2;
}
__device__ __forceinline__ f32x2 swiglu_fold(f32x2 x, f32x2 y) {
    f32x2 e; e.x = __builtin_amdgcn_exp2f(x.x); e.y = __builtin_amdgcn_exp2f(x.y);
    const f32x2 d = e + 1.0f; f32x2 r; r.x = __builtin_amdgcn_rcpf(d.x); r.y = __builtin_amdgcn_rcpf(d.y);
    return (x * y) * r;
}
struct EpiSwiGLU {
    static constexpr bool PERM2 = false;
    bf16_t* O; int ldc;
    __device__ __forceinline__ void operator()(const f32x4 (&acc)[2][2][4][2], const Unit& u, int wr, int wc, int fr, int fq) const {
        const int row0 = u.om * BM + wr * 64 + fr, col0 = u.on * HALF + wc * 32 + 8 * fq;
#pragma unroll
        for (int ai = 0; ai < 2; ++ai)
#pragma unroll
            for (int m = 0; m < 4; ++m) { bf16_t* rowp = O + (size_t)(row0 + ai * HALF + m * 16) * ldc + col0;
                f32x4 o0, o1;
#pragma unroll
                for (int j = 0; j < 4; ++j) { o0[j] = silu_f(acc[ai][0][m][0][j]) * acc[ai][1][m][0][j]; o1[j] = silu_f(acc[ai][0][m][1][j]) * acc[ai][1][m][1][j]; }
                u32x4 w; w.x = cvt_pk_bf16(o0[0], o0[1]); w.y = cvt_pk_bf16(o0[2], o0[3]); w.z = cvt_pk_bf16(o1[0], o1[1]); w.w = cvt_pk_bf16(o1[2], o1[3]);
                *(u32x4*)rowp = w; }
    }
};
struct EpiSwiGLU8 {
    static constexpr bool PERM2 = true;
    static constexpr int WSCALE = 0x78787878;
    unsigned char* O; int ldc; float ds;
    __device__ __forceinline__ void operator()(const f32x4 (&acc)[2][2][4][2], const Unit& u, int wr, int wc, int fr, int fq) const {
        unsigned char* blk = O + (size_t)(u.om * (ldc >> 7) + u.on) * (BM * 128);
        const int lo = (wr * 64 + fr + ((fq >> 1) ? 16 : 0)) * 128 + wc * 32 + 16 * (fq & 1);
#pragma unroll
        for (int ai = 0; ai < 2; ++ai)
#pragma unroll
            for (int mp = 0; mp < 2; ++mp) {
                u32x2 w[2];
#pragma unroll
                for (int mo = 0; mo < 2; ++mo) { const int m = 2 * mp + mo;
                    const f32x4 xa0 = acc[ai][0][m][0], xb0 = acc[ai][1][m][0], xa1 = acc[ai][0][m][1], xb1 = acc[ai][1][m][1];
                    const f32x2 p0 = swiglu_fold((f32x2){xa0[0], xa0[1]}, (f32x2){xb0[0], xb0[1]}), p1 = swiglu_fold((f32x2){xa0[2], xa0[3]}, (f32x2){xb0[2], xb0[3]});
                    const f32x2 p2 = swiglu_fold((f32x2){xa1[0], xa1[1]}, (f32x2){xb1[0], xb1[1]}), p3 = swiglu_fold((f32x2){xa1[2], xa1[3]}, (f32x2){xb1[2], xb1[3]});
                    w[mo].x = cvt_pk4_fp8(p0.x, p0.y, p1.x, p1.y); w[mo].y = cvt_pk4_fp8(p2.x, p2.y, p3.x, p3.y); }
                const auto sx = __builtin_amdgcn_permlane32_swap(w[0].x, w[1].x, false, false), sy = __builtin_amdgcn_permlane32_swap(w[0].y, w[1].y, false, false);
                u32x4 o; o.x = sx[0]; o.y = sy[0]; o.z = sx[1]; o.w = sy[1];
                *(u32x4*)(blk + (lo + (ai * HALF + mp * 32) * 128)) = o; }
    }
};
struct EpiSwiGLUi8 {
    static constexpr bool PERM2 = true;
    unsigned char* O; int ldc; const float* rs; const unsigned* cmax;
    __device__ __forceinline__ void operator()(const f32x4 (&acc)[2][2][4][2], const Unit& u, int wr, int wc, int fr, int fq, const LAS float* sd) const {
        const int rowl = wr * 64 + fr, rows = u.om * BM + rowl + ((fq >> 1) ? 16 : 0), col0 = u.on * HALF + wc * 32 + 16 * (fq & 1);
        const int brow0 = 256 + wc * 32 + 16 * (fq & 1) + 8 * (fq >> 1);
        const LAS unsigned* cmax = (const LAS unsigned*)sd; const LAS float* rs = sd;
        f32x4 ca[2], cb[2];
#pragma unroll
        for (int n = 0; n < 2; ++n) { const u32x4 wa = *(const LAS u32x4*)(cmax + brow0 + 4 * n), wb = *(const LAS u32x4*)(cmax + brow0 + HALF + 4 * n);
#pragma unroll
            for (int j = 0; j < 4; ++j) { ca[n][j] = __uint_as_float(wa[j]) * (1.0f / 127.0f); cb[n][j] = __uint_as_float(wb[j]) * (1.0f / 127.0f); } }
#pragma unroll
        for (int ai = 0; ai < 2; ++ai)
#pragma unroll
            for (int mp = 0; mp < 2; ++mp) {
                u32x2 w[2];
#pragma unroll
                for (int mo = 0; mo < 2; ++mo) { const int m = 2 * mp + mo; const float rsv = rs[rowl + ai * HALF + m * 16];
                    f32x2 o[2][2];
#pragma unroll
                    for (int n = 0; n < 2; ++n)
#pragma unroll
                        for (int jp = 0; jp < 2; ++jp) {
                            const f32x2 x = {(float)__float_as_int(acc[ai][0][m][n][2 * jp]), (float)__float_as_int(acc[ai][0][m][n][2 * jp + 1])}, y = {(float)__float_as_int(acc[ai][1][m][n][2 * jp]), (float)__float_as_int(acc[ai][1][m][n][2 * jp + 1])};
                            const f32x2 sa = (f32x2){ca[n][2 * jp], ca[n][2 * jp + 1]} * rsv, sb = (f32x2){cb[n][2 * jp], cb[n][2 * jp + 1]} * rsv;
                            o[n][jp] = swiglu_pk(x, y, sa * (-1.44269504089f), sa * sb); }
                    w[mo].x = cvt_pk4_fp8(o[0][0].x, o[0][0].y, o[0][1].x, o[0][1].y); w[mo].y = cvt_pk4_fp8(o[1][0].x, o[1][0].y, o[1][1].x, o[1][1].y); }
                const auto sx = __builtin_amdgcn_permlane32_swap(w[0].x, w[1].x, false, false), sy = __builtin_amdgcn_permlane32_swap(w[0].y, w[1].y, false, false);
                u32x4 o16; o16.x = sx[0]; o16.y = sy[0]; o16.z = sx[1]; o16.w = sy[1];
                *(u32x4*)(O + (size_t)(rows + ai * HALF + mp * 32) * ldc + col0) = o16; }
    }
};
struct EpiConvIni8 {
    static constexpr bool PERM2 = false;
    bf16_t* BG; bf16_t* U; const float* rs; const unsigned* cmax;
    __device__ __forceinline__ void operator()(const f32x4 (&acc)[2][2][4][2], const Unit& u, int wr, int wc, int fr, int fq, const LAS float* sd) const {
        const int rl0 = wr * 64 + fr, row0 = u.om * BM + rl0, brow0 = 256 + wc * 32 + 8 * fq;
        const LAS unsigned* cmax = (const LAS unsigned*)sd;
        f32x4 cs[2][2];
#pragma unroll
        for (int bj = 0; bj < 2; ++bj)
#pragma unroll
            for (int n = 0; n < 2; ++n) { const u32x4 w = *(const LAS u32x4*)(cmax + brow0 + bj * HALF + 4 * n);
#pragma unroll
                for (int j = 0; j < 4; ++j) cs[bj][n][j] = __uint_as_float(w[j]) * (1.0f / 127.0f); }
#pragma unroll
        for (int ai = 0; ai < 2; ++ai)
#pragma unroll
            for (int m = 0; m < 4; ++m) { const int r = row0 + ai * HALF + m * 16; const float rsv = sd[rl0 + ai * HALF + m * 16];
                f32x4 v[2][2];
#pragma unroll
                for (int bj = 0; bj < 2; ++bj)
#pragma unroll
                    for (int n = 0; n < 2; ++n)
#pragma unroll
                        for (int j = 0; j < 4; ++j) v[bj][n][j] = (float)__float_as_int(acc[ai][bj][m][n][j]) * (rsv * cs[bj][n][j]);
                if (u.on < 4) { bf16_t* rowp = BG + (size_t)r * D + u.on * BM + wc * 32 + 8 * fq;
#pragma unroll
                    for (int bj = 0; bj < 2; ++bj) { u32x4 w; w.x = cvt_pk_bf16(v[bj][0][0], v[bj][0][1]); w.y = cvt_pk_bf16(v[bj][0][2], v[bj][0][3]); w.z = cvt_pk_bf16(v[bj][1][0], v[bj][1][1]); w.w = cvt_pk_bf16(v[bj][1][2], v[bj][1][3]);
                        *(u32x4*)(rowp + bj * HALF) = w; } }
                else { bf16_t* rowp = U + (size_t)r * D + (u.on - 4) * HALF + wc * 32 + 8 * fq;
                    const f32x4 o0 = v[0][0] * v[1][0], o1 = v[0][1] * v[1][1];
                    u32x4 w; w.x = cvt_pk_bf16(o0[0], o0[1]); w.y = cvt_pk_bf16(o0[2], o0[3]); w.z = cvt_pk_bf16(o1[0], o1[1]); w.w = cvt_pk_bf16(o1[2], o1[3]);
                    *(u32x4*)rowp = w; } }
    }
};
struct EpiConvIn {
    static constexpr bool PERM2 = false;
    bf16_t* BG; bf16_t* U;
    __device__ __forceinline__ void operator()(const f32x4 (&acc)[2][2][4][2], const Unit& u, int wr, int wc, int fr, int fq) const {
        if (u.on < 4) { EpiPlain e{BG, D, 1.0f}; e(acc, u, wr, wc, fr, fq); return; }
        const int row0 = u.om * BM + wr * 64 + fr, col0 = (u.on - 4) * HALF + wc * 32 + 8 * fq;
#pragma unroll
        for (int ai = 0; ai < 2; ++ai)
#pragma unroll
            for (int m = 0; m < 4; ++m) { bf16_t* rowp = U + (size_t)(row0 + ai * HALF + m * 16) * D + col0;
                const f32x4 o0 = acc[ai][0][m][0] * acc[ai][1][m][0], o1 = acc[ai][0][m][1] * acc[ai][1][m][1];
                u32x4 w; w.x = cvt_pk_bf16(o0[0], o0[1]); w.y = cvt_pk_bf16(o0[2], o0[3]); w.z = cvt_pk_bf16(o1[0], o1[1]); w.w = cvt_pk_bf16(o1[2], o1[3]);
                *(u32x4*)rowp = w; }
    }
};
struct EpiQKV {
    static constexpr bool PERM2 = false;
    static constexpr int WSCALE = 0x78787878;
    bf16_t *q, *k, *v, *kc, *vc; const LAS float* rope;
    __device__ __forceinline__ void operator()(const f32x4 (&acc)[2][2][4][2], const Unit& u, int wr, int wc, int fr, int fq) const {
        const bool ctx = u.om >= 128;
        const int row0 = u.om * BM + wr * 64 + fr - (ctx ? T : 0);
        const int ct0 = wc * 32 + 8 * fq;
        bf16_t* base; int ldc, colb; bool rot = false;
        if (u.on < 4) { base = q; ldc = D; colb = u.on * BM; rot = true; }
        else if (u.on == 4) { base = ctx ? kc : k; ldc = 256; colb = 0; rot = !ctx; }
        else { base = ctx ? vc : v; ldc = 256; colb = 0; }
#pragma unroll
        for (int ai = 0; ai < 2; ++ai)
#pragma unroll
            for (int m = 0; m < 4; ++m) {
                const int r = row0 + ai * HALF + m * 16;
                bf16_t* rowp = base + (size_t)r * ldc + colb + ct0;
                f32x4 cs0 = {1.f, 0.f, 1.f, 0.f}, cs1 = {1.f, 0.f, 1.f, 0.f};
                if (rot) { const int s = r & (SEQ - 1); const int pos = (wc & 1) ? (s & 63) : (s >> 6);
                    const LAS f32x4* tp = (const LAS f32x4*)(rope + (pos * 16 + 4 * fq) * 2); cs0 = tp[0]; cs1 = tp[1]; }
#pragma unroll
                for (int bj = 0; bj < 2; ++bj) { const f32x4 v0 = acc[ai][bj][m][0], v1 = acc[ai][bj][m][1];
                    f32x4 o0, o1;
                    o0[0] = v0[0] * cs0[0] - v1[0] * cs0[1]; o1[0] = v1[0] * cs0[0] + v0[0] * cs0[1];
                    o0[1] = v0[1] * cs0[2] - v1[1] * cs0[3]; o1[1] = v1[1] * cs0[2] + v0[1] * cs0[3];
                    o0[2] = v0[2] * cs1[0] - v1[2] * cs1[1]; o1[2] = v1[2] * cs1[0] + v0[2] * cs1[1];
                    o0[3] = v0[3] * cs1[2] - v1[3] * cs1[3]; o1[3] = v1[3] * cs1[2] + v0[3] * cs1[3];
                    u32x4 w; w.x = cvt_pk_bf16(o0[0], o0[1]); w.y = cvt_pk_bf16(o0[2], o0[3]); w.z = cvt_pk_bf16(o1[0], o1[1]); w.w = cvt_pk_bf16(o1[2], o1[3]);
                    *(u32x4*)(rowp + bj * HALF) = w; } }
    }
};

template <class E> constexpr auto wscale_of(int) -> decltype(E::WSCALE) { return E::WSCALE; }
template <class E> constexpr int wscale_of(long) { return 0x7F7F7F7F; }
template <class E> constexpr auto ascale_of(int) -> decltype(E::ASCALE) { return E::ASCALE; }
template <class E> constexpr int ascale_of(long) { return 0x7F7F7F7F; }
template <int MODE  , class Epi, class Sched, bool BLK = false>
__device__ __forceinline__ void gemm_phase(LAS unsigned char* lds, const Gemm g, const Sched& S, const Epi& E) {
    const int tid = threadIdx.x, wid = __builtin_amdgcn_readfirstlane(tid >> 6), lane = tid & 63, wr = wid >> 2, wc = wid & 3, fr = lane & 15, fq = lane >> 4;
    constexpr bool FP8 = (MODE == 1);
    const int K = MODE ? g.K / 2 : g.K, nt = K / BK;
    unsigned voffA[2], voffB[2];
#pragma unroll
    for (int i = 0; i < 2; ++i) { int R, C; stage_rc(tid * 16 + i * 8192, R, C); const int Rb = (R & ~31) + (Epi::PERM2 ? perm32b(R & 31) : perm32(R & 31));
        voffA[i] = (unsigned)(R * (BLK ? BK : K) + C) * 2u; voffB[i] = (unsigned)(Rb * (BLK ? BK : K) + C) * 2u; }
    const unsigned kstep = BLK ? (unsigned)(BM * BK * 2) : (unsigned)(BK * 2);
    const unsigned hstep = BLK ? (unsigned)(HALF * BK * 2) : (unsigned)HALF * K * 2;
    const unsigned tstep = BLK ? (unsigned)nt * (unsigned)(BM * BK * 2) : 2 * hstep;
    const __amdgpu_buffer_rsrc_t rsA = __builtin_amdgcn_make_buffer_rsrc((void*)g.A, (short)0, 0x7fffffff, 0x00020000);
    const __amdgpu_buffer_rsrc_t rsB = __builtin_amdgcn_make_buffer_rsrc((void*)g.Bt, (short)0, 0x7fffffff, 0x00020000);
    const unsigned ldsw = (unsigned)wid * 1024u;
    LAS float* sideb = (LAS float*)(lds + MISC_OFF + 4096);
    const int aoff = lds_byte(wr * 64 + fr, fq * 8), boff = lds_byte(wc * 32 + fr, fq * 8);
#define PG8_SA(b, h) (((b) * 2 + (h)) * HTB)
#define PG8_SB(b, h) ((4 + (b) * 2 + (h)) * HTB)
#define PG8_STAGE(bufoff, gbase, voff) do { _Pragma("unroll") for (int _i = 0; _i < 2; ++_i) \
        __builtin_amdgcn_raw_ptr_buffer_load_lds(PG8_RS_##voff, (LAS void*)(lds + (bufoff) + ldsw + _i * 8192), 16, (voff)[_i], (gbase), 0, 0); } while (0)
#define PG8_RS_voffA rsA
#define PG8_RS_voffB rsB
#define PG8_LDA(dst, b, h) do { _Pragma("unroll") for (int m = 0; m < 4; ++m) _Pragma("unroll") for (int k = 0; k < 2; ++k) dst[m][k] = *(const LAS bf16x8*)(lds + PG8_SA(b, h) + aoff + m * 2048 + k * 1024); } while (0)
#define PG8_LDB(dst, b, h) do { _Pragma("unroll") for (int n = 0; n < 2; ++n) _Pragma("unroll") for (int k = 0; k < 2; ++k) dst[n][k] = *(const LAS bf16x8*)(lds + PG8_SB(b, h) + boff + n * 2048 + k * 1024); } while (0)
#define PG8_MMA(ai, bj, At, Bt) do { __builtin_amdgcn_s_setprio(1); _Pragma("unroll") for (int m = 0; m < 4; ++m) _Pragma("unroll") for (int n = 0; n < 2; ++n) { \
        if constexpr (FP8) { const v8i a8 = __builtin_shufflevector(__builtin_bit_cast(v4i, At[m][0]), __builtin_bit_cast(v4i, At[m][1]), 0, 1, 2, 3, 4, 5, 6, 7); \
            const v8i b8 = __builtin_shufflevector(__builtin_bit_cast(v4i, Bt[n][0]), __builtin_bit_cast(v4i, Bt[n][1]), 0, 1, 2, 3, 4, 5, 6, 7); \
            acc[ai][bj][m][n] = __builtin_amdgcn_mfma_scale_f32_16x16x128_f8f6f4(b8, a8, acc[ai][bj][m][n], 0, 0, 0, wscale_of<Epi>(0), 0, ascale_of<Epi>(0)); } \
        else if constexpr (MODE == 2) { _Pragma("unroll") for (int k = 0; k < 2; ++k) acc[ai][bj][m][n] = __builtin_bit_cast(f32x4, __builtin_amdgcn_mfma_i32_16x16x64_i8(__builtin_bit_cast(v4i, Bt[n][k]), __builtin_bit_cast(v4i, At[m][k]), __builtin_bit_cast(v4i, acc[ai][bj][m][n]), 0, 0, 0)); } \
        else { _Pragma("unroll") for (int k = 0; k < 2; ++k) acc[ai][bj][m][n] = __builtin_amdgcn_mfma_f32_16x16x32_bf16(Bt[n][k], At[m][k], acc[ai][bj][m][n], 0, 0, 0); } } \
        __builtin_amdgcn_s_setprio(0); } while (0)
#define PG8_WAIT_V(n) asm volatile("s_waitcnt vmcnt(" #n ")" ::: "memory")
#define PG8_WAIT_L(n) asm volatile("s_waitcnt lgkmcnt(" #n ")" ::: "memory")
#define PG8_SIDE(u_, par_) do { const __amdgpu_buffer_rsrc_t rsS_ = __builtin_amdgcn_make_buffer_rsrc((wid < 4) ? (void*)E.rs : (void*)E.cmax, (short)0, 0x7fffffff, 0x00020000); \
        __builtin_amdgcn_raw_ptr_buffer_load_lds(rsS_, (LAS void*)(sideb + (par_) * 512 + ((wid < 4) ? 0 : 256) + (wid & 3) * 64), 4, (unsigned)(((wid & 3) * 64 + lane) * 4), \
            __builtin_amdgcn_readfirstlane((unsigned)(((wid < 4) ? (u_).om : (u_).on) * 1024)), 0, 0); } while (0)
#define PG8_BAR __builtin_amdgcn_s_barrier()
#define PG8_SCHED __builtin_amdgcn_sched_barrier(0)
    Unit cur, nxt; int ui = 0;
    if (!S.next(0, cur)) return;
    f32x4 acc[2][2][4][2];
#pragma unroll
    for (int a = 0; a < 2; ++a)
#pragma unroll
        for (int b = 0; b < 2; ++b)
#pragma unroll
            for (int m = 0; m < 4; ++m)
#pragma unroll
                for (int n = 0; n < 2; ++n) acc[a][b][m][n] = (f32x4){0.f, 0.f, 0.f, 0.f};
    bf16x8 At[4][2], B0[2][2], B1[2][2];
    unsigned cA = __builtin_amdgcn_readfirstlane((unsigned)cur.am * tstep), cB = __builtin_amdgcn_readfirstlane((unsigned)cur.bn * tstep);
    if constexpr (MODE == 2) PG8_SIDE(cur, 0);
    PG8_STAGE(PG8_SB(0, 0), cB, voffB); PG8_STAGE(PG8_SB(0, 1), cB + hstep, voffB); PG8_STAGE(PG8_SA(0, 0), cA, voffA); PG8_STAGE(PG8_SA(0, 1), cA + hstep, voffA);
    if (wr == 1) PG8_BAR;
    PG8_WAIT_V(2); PG8_BAR;
    PG8_STAGE(PG8_SB(1, 0), cB + kstep, voffB); PG8_STAGE(PG8_SA(1, 0), cA + kstep, voffA); PG8_STAGE(PG8_SB(1, 1), cB + hstep + kstep, voffB);
    PG8_WAIT_V(6); PG8_BAR;
    for (;;) {
        const bool has_next = S.next(ui + 1, nxt);
        const unsigned nA = __builtin_amdgcn_readfirstlane(has_next ? (unsigned)nxt.am * tstep : cA), nB = __builtin_amdgcn_readfirstlane(has_next ? (unsigned)nxt.bn * tstep : cB);
#pragma unroll 1
        for (int t = 0; t < nt; t += 2) {
            const bool last = (t == nt - 2);
            const unsigned a1 = __builtin_amdgcn_readfirstlane(cA + (unsigned)(t + 1) * kstep);
            const unsigned a2 = __builtin_amdgcn_readfirstlane(last ? nA : cA + (unsigned)(t + 2) * kstep), b2 = __builtin_amdgcn_readfirstlane(last ? nB : cB + (unsigned)(t + 2) * kstep);
            const unsigned a3 = a2 + kstep, b3 = b2 + kstep;
            PG8_LDB(B0, 0, 0); PG8_LDB(B1, 0, 1); PG8_SCHED; PG8_LDA(At, 0, 0); PG8_STAGE(PG8_SA(1, 1), a1 + hstep, voffA);
            PG8_WAIT_V(8); PG8_WAIT_L(0); PG8_BAR; PG8_MMA(0, 0, At, B0); PG8_MMA(0, 1, At, B1); PG8_BAR; PG8_SCHED;
            PG8_LDA(At, 0, 1); PG8_STAGE(PG8_SB(0, 0), b2, voffB); PG8_STAGE(PG8_SB(0, 1), b2 + hstep, voffB); PG8_STAGE(PG8_SA(0, 0), a2, voffA);
            PG8_WAIT_V(8); PG8_WAIT_L(0); PG8_BAR; PG8_MMA(1, 0, At, B0); PG8_MMA(1, 1, At, B1); PG8_BAR; PG8_SCHED;
            PG8_LDB(B0, 1, 0); PG8_LDB(B1, 1, 1); PG8_SCHED; PG8_LDA(At, 1, 0); PG8_STAGE(PG8_SA(0, 1), a2 + hstep, voffA);
            PG8_WAIT_V(8); PG8_WAIT_L(0); PG8_BAR; PG8_MMA(0, 0, At, B0); PG8_MMA(0, 1, At, B1); PG8_BAR; PG8_SCHED;
            PG8_LDA(At, 1, 1); PG8_STAGE(PG8_SB(1, 0), b3, voffB); PG8_STAGE(PG8_SB(1, 1), b3 + hstep, voffB); PG8_STAGE(PG8_SA(1, 0), a3, voffA);
            PG8_WAIT_V(8); PG8_WAIT_L(0); PG8_BAR; PG8_MMA(1, 0, At, B0); PG8_MMA(1, 1, At, B1); PG8_BAR; PG8_SCHED;
        }
        if (wr == 0) PG8_BAR;
        { const int ln_ = (int)__builtin_amdgcn_mbcnt_hi(~0u, __builtin_amdgcn_mbcnt_lo(~0u, 0u)); int fr_ = ln_ & 15, fq_ = ln_ >> 4;
          asm volatile("" : "+v"(fr_), "+v"(fq_));
          if constexpr (MODE == 2) { E(acc, cur, wr, wc, fr_, fq_, sideb + (ui & 1) * 512); if (has_next) PG8_SIDE(nxt, (ui + 1) & 1); } else E(acc, cur, wr, wc, fr_, fq_); }
        if (!has_next) break;
#pragma unroll
        for (int a = 0; a < 2; ++a)
#pragma unroll
            for (int b = 0; b < 2; ++b)
#pragma unroll
                for (int m = 0; m < 4; ++m)
#pragma unroll
                    for (int n = 0; n < 2; ++n) acc[a][b][m][n] = (f32x4){0.f, 0.f, 0.f, 0.f};
        cur = nxt; cA = nA; cB = nB; ++ui;
        if (wr == 1) PG8_BAR;
    }
    PG8_WAIT_V(0);
    PG8_BAR;
#undef PG8_SA
#undef PG8_SB
#undef PG8_STAGE
#undef PG8_RS_voffA
#undef PG8_RS_voffB
#undef PG8_LDA
#undef PG8_LDB
#undef PG8_MMA
#undef PG8_WAIT_V
#undef PG8_WAIT_L
#undef PG8_SIDE
#undef PG8_BAR
#undef PG8_SCHED
}
}

struct Args {
    const float* in[21];
    float* out; unsigned char* ws;
    int ph_lo, ph_hi;
};
enum { I_X = 0, I_C, I_CTX, I_CCTX, I_WMOD, I_BMOD, I_LNG, I_LNB, I_WQKV, I_WO, I_SINK, I_CWIN, I_CW, I_CWOUT, I_W1, I_W3, I_W2, I_ROUTER, I_MW1, I_MW3, I_MW2 };

__device__ __forceinline__ void p0_load_tile(const float* src, int ld, int col0, int k0, LAS float* scr, int lane) {
    f32x4 v[8]; const int c4 = (lane & 7) * 4, kr = lane >> 3;
#pragma unroll
    for (int i = 0; i < 8; ++i) v[i] = __builtin_nontemporal_load((const f32x4*)(src + (size_t)(k0 + kr + 8 * i) * ld + col0 + c4));
#pragma unroll
    for (int i = 0; i < 8; ++i) { LAS float* p = scr + (kr + 8 * i) * 33 + c4; p[0] = v[i][0]; p[1] = v[i][1]; p[2] = v[i][2]; p[3] = v[i][3]; }
    LDS_WAIT(); asm volatile("" ::: "memory");
}
__device__ __forceinline__ void p0_transpose_item(const float* src, int ld, int col0, int k0, bf16_t* dst, int K, bool permq, LAS float* scr, int lane) {
    p0_load_tile(src, ld, col0, k0, scr, lane);
    const int c = lane & 7;
#pragma unroll
    for (int j = 0; j < 4; ++j) { const int n = (lane >> 3) + 8 * j;
        const int ns = permq ? (16 * ((n >> 2) & 1) + 4 * (n >> 3) + (n & 3)) : n;
        const LAS float* s = scr + (8 * c) * 33 + ns;
        u32x4 o; o.x = cvt_pk_bf16(s[0 * 33], s[1 * 33]); o.y = cvt_pk_bf16(s[2 * 33], s[3 * 33]); o.z = cvt_pk_bf16(s[4 * 33], s[5 * 33]); o.w = cvt_pk_bf16(s[6 * 33], s[7 * 33]);
        *(u32x4*)(dst + (size_t)n * K + 8 * c) = o; }
    LDS_WAIT(); asm volatile("" ::: "memory");
}
__device__ __forceinline__ void p0_absmax_item(const float* src, int ld, int col0, int k0, unsigned* cmax, int lane) {
    f32x4 v[8]; const int c4 = (lane & 7) * 4, kr = lane >> 3;
#pragma unroll
    for (int i = 0; i < 8; ++i) v[i] = *(const f32x4*)(src + (size_t)(k0 + kr + 8 * i) * ld + col0 + c4);
    f32x4 mx = {0.f, 0.f, 0.f, 0.f};
#pragma unroll
    for (int i = 0; i < 8; ++i)
#pragma unroll
        for (int j = 0; j < 4; ++j) mx[j] = fmaxf(mx[j], fabsf(v[i][j]));
#pragma unroll
    for (int j = 0; j < 4; ++j) { float m = mx[j]; m = fmaxf(m, __shfl_xor(m, 8)); m = fmaxf(m, __shfl_xor(m, 16)); m = fmaxf(m, __shfl_xor(m, 32)); mx[j] = m; }
    if (lane < 8) {
#pragma unroll
        for (int j = 0; j < 4; ++j) atomicMax(cmax + c4 + j, __float_as_uint(mx[j])); }
}
__device__ __forceinline__ void p0_transpose_item_i8(const float* src, int ld, int col0, int k0, unsigned char* dst, int K, const unsigned* cmax, LAS float* scr, int lane) {
    p0_load_tile(src, ld, col0, k0, scr, lane);
    const int c = lane & 7;
#pragma unroll
    for (int j = 0; j < 4; ++j) { const int n = (lane >> 3) + 8 * j;
        const float am = __uint_as_float(cmax[n]); const float sc = am > 0.f ? 127.0f / am : 0.f;
        const LAS float* s = scr + (8 * c) * 33 + n;
        u32x2 o; o.x = pk4_i8(s[0 * 33] * sc, s[1 * 33] * sc, s[2 * 33] * sc, s[3 * 33] * sc); o.y = pk4_i8(s[4 * 33] * sc, s[5 * 33] * sc, s[6 * 33] * sc, s[7 * 33] * sc);
        *(u32x2*)(dst + (size_t)n * K + 8 * c) = o; }
    LDS_WAIT(); asm volatile("" ::: "memory");
}
__device__ __forceinline__ void p0_transpose_item8(const float* src, int ld, int col0, int k0, unsigned char* dst, int K, float sc, LAS float* scr, int lane, bool permq = false) {
    p0_load_tile(src, ld, col0, k0, scr, lane);
    const int c = lane & 7;
#pragma unroll
    for (int j = 0; j < 4; ++j) { const int n = (lane >> 3) + 8 * j;
        const int ns = permq ? (16 * ((n >> 2) & 1) + 4 * (n >> 3) + (n & 3)) : n;
        const LAS float* s = scr + (8 * c) * 33 + ns;
        u32x2 o; o.x = cvt_pk4_fp8(s[0 * 33] * sc, s[1 * 33] * sc, s[2 * 33] * sc, s[3 * 33] * sc); o.y = cvt_pk4_fp8(s[4 * 33] * sc, s[5 * 33] * sc, s[6 * 33] * sc, s[7 * 33] * sc);
        *(u32x2*)(dst + (size_t)n * K + 8 * c) = o; }
    LDS_WAIT(); asm volatile("" ::: "memory");
}
__device__ __forceinline__ void p0_prologue(const Args& a, LAS unsigned char* lds, int G, int bx) {
    const int tid = threadIdx.x, lane = tid & 63, wave = __builtin_amdgcn_readfirstlane(tid >> 6);
    unsigned char* ws = a.ws;
    for (int task = bx; task < 192; task += G) {
        const int layer = task / 96, col0 = 64 * (task % 96);
        LAS float* sl = (LAS float*)lds;
        LAS float* part = (LAS float*)(lds + 17 * 1024 * 4);
        { f32x4 cv[9];
#pragma unroll
          for (int i = 0; i < 9; ++i) { const int q = tid + 512 * i; if (q < 4352) cv[i] = (q >> 8) < 16 ? *(const f32x4*)(a.in[I_C] + 4 * q) : *(const f32x4*)(a.in[I_CCTX] + 4 * (q & 255)); }
#pragma unroll
          for (int i = 0; i < 9; ++i) { const int q = tid + 512 * i; if (q < 4352) { f32x4 o;
#pragma unroll
                  for (int j = 0; j < 4; ++j) o[j] = cv[i][j] / (1.0f + __expf(-cv[i][j]));
                  *(LAS f32x4*)(sl + 4 * q) = o; } } }
        __syncthreads();
        const int cg = tid & 15, ks = tid >> 4;
        f32x4 acc[17];
#pragma unroll
        for (int b = 0; b < 17; ++b) acc[b] = (f32x4){0.f, 0.f, 0.f, 0.f};
        const float* wp = a.in[I_WMOD] + (size_t)layer * 1024 * 6144 + col0 + 4 * cg;
#pragma unroll 1
        for (int k16 = 0; k16 < 2; ++k16) { f32x4 w[16];
#pragma unroll
            for (int u = 0; u < 16; ++u) w[u] = __builtin_nontemporal_load((const f32x4*)(wp + (size_t)(ks + 32 * (16 * k16 + u)) * 6144));
#pragma unroll
            for (int u = 0; u < 16; ++u) { const int kk = ks + 32 * (16 * k16 + u);
#pragma unroll
                for (int b = 0; b < 17; ++b) acc[b] += w[u] * sl[b * 1024 + kk]; } }
#pragma unroll
        for (int b = 0; b < 17; ++b)
#pragma unroll
            for (int j = 0; j < 4; ++j) { float v = acc[b][j]; v += __shfl_xor(v, 16); v += __shfl_xor(v, 32); acc[b][j] = v; }
        if (lane < 16) {
#pragma unroll
            for (int b = 0; b < 17; ++b) *(LAS f32x4*)(part + (wave * 17 + b) * 64 + 4 * cg) = acc[b]; }
        __syncthreads();
        float* modv = (float*)(ws + WS_MODV) + (size_t)layer * 17 * 6144;
        for (int idx = tid; idx < 17 * 64; idx += 512) { const int b = idx >> 6, cc = idx & 63; float s = a.in[I_BMOD][layer * 6144 + col0 + cc];
#pragma unroll
            for (int w = 0; w < 8; ++w) s += part[(w * 17 + b) * 64 + cc];
            modv[(size_t)b * 6144 + col0 + cc] = s; }
        __syncthreads();
    }
    if (bx == G - 1) { for (int idx = tid; idx < 1024; idx += 512) { const int pos = idx >> 4, j = idx & 15;
            const float inv = exp2f(-(float)j * (13.287712379549449f / 16.0f));
            const float ang = (float)pos * inv; float s, c; sincosf(ang, &s, &c);
            float* rp = (float*)(ws + WS_ROPE) + idx * 2; rp[0] = c; rp[1] = s; } }
    LAS float* scr = (LAS float*)(lds + wave * 16384);
    const int gw = bx * NWAVES + wave, NGW = G * NWAVES;
    constexpr int I1 = 16 * 48, I2 = 16 * 32, I3 = 16 * 176, I4 = 44 * 32, I5 = 16 * 96, I6 = 16 * 32, I7 = NE * 16 * 224, I8 = NE * 56 * 32;
    constexpr int NITEMS = I1 + I2 + I3 + I4 + I5 + I6;
    (void)I7; (void)I8;
    __syncthreads();
    for (int it = gw; it < NITEMS; it += NGW) {
        int r = it;
        if (r < I1) { const int kb = r / 48, nb = r % 48; p0_transpose_item8(a.in[I_WQKV], NQKV, 32 * nb, 64 * kb, (unsigned char*)(ws + WS_WQKV) + (size_t)(32 * nb) * D + 64 * kb, D, nb < 32 ? 128.0f * 0.125f * 1.44269504089f : 128.0f, scr, lane, nb < 40); continue; } r -= I1;
        if (r < I2) { const int kb = r / 32, nb = r % 32; p0_transpose_item8(a.in[I_WO], D, 32 * nb, 64 * kb, (unsigned char*)(ws + WS_WO) + (size_t)(32 * nb) * D + 64 * kb, D, 256.0f, scr, lane); continue; } r -= I2;
        if (r < I3) { const int kb = r / 176, nb = r % 176, t = nb >> 3, sub = nb & 7;
            p0_absmax_item(sub < 4 ? a.in[I_W1] : a.in[I_W3], DFF, 128 * t + 32 * (sub & 3), 64 * kb, (unsigned*)(ws + WS_CMAX13) + 32 * nb, lane); continue; } r -= I3;
        if (r < I4) { const int kb = r / 32, nb = r % 32; p0_transpose_item8(a.in[I_W2], D, 32 * nb, 64 * kb, (unsigned char*)(ws + WS_W2) + (size_t)(32 * nb) * DFF + 64 * kb, DFF, 512.0f, scr, lane); continue; } r -= I4;
        if (r < I5) { const int kb = r / 96, nb = r % 96; int col0;
            if (nb < 32) col0 = 32 * nb; else { const int n2 = nb - 32, t = n2 >> 3, sub = n2 & 7; col0 = (sub < 4 ? 1024 : 2048) + 128 * t + 32 * (sub & 3); }
            p0_absmax_item(a.in[I_CWIN], 3 * D, col0, 64 * kb, (unsigned*)(ws + WS_CMAXCIN) + 32 * nb, lane); continue; } r -= I5;
        { const int kb = r / 32, nb = r % 32; p0_transpose_item(a.in[I_CWOUT], D, 32 * nb, 64 * kb, (bf16_t*)(ws + WS_WCOUT) + (size_t)(32 * nb) * D + 64 * kb, D, false, scr, lane); }
    }
}
constexpr int MOE_I7 = NE * 16 * 224, MOE_I8 = NE * 56 * 32, MOE_ITEMS = MOE_I7 + MOE_I8;
__device__ __forceinline__ bool moe_item(const Args& a, LAS unsigned char* lds, int wave, int lane) {
    LAS unsigned* q = (LAS unsigned*)(lds + MISC_OFF);
    unsigned itu = 0u; if (lane == 0) itu = __hip_atomic_fetch_add(q, 1u, __ATOMIC_RELAXED, __HIP_MEMORY_SCOPE_WORKGROUP);
    int r = (int)__builtin_amdgcn_readfirstlane(itu) * (int)gridDim.x + (int)blockIdx.x;
    if (r >= MOE_ITEMS) return false;
    LAS float* scr = (LAS float*)(lds + wave * 16384);
    unsigned char* ws = a.ws;
    if (r < MOE_I7) { const int e = r / 3584, r2 = r % 3584, kb = r2 / 224, nb = r2 % 224, t = nb >> 3, sub = nb & 7;
        p0_transpose_item8((sub < 4 ? a.in[I_MW1] : a.in[I_MW3]) + (size_t)e * D * DFE, DFE, 128 * t + 32 * (sub & 3), 64 * kb, (unsigned char*)(ws + WS_WM13) + ((size_t)e * 2 * DFE + 32 * nb) * D + 64 * kb, D, sub < 4 ? -128.0f * 1.44269504089f : -128.0f / 1.44269504089f, scr, lane); }
    else { r -= MOE_I7; const int e = r / 1792, r2 = r % 1792, kb = r2 / 32, nb = r2 % 32;
        p0_transpose_item8(a.in[I_MW2] + (size_t)e * DFE * D, D, 32 * nb, 64 * kb, (unsigned char*)(ws + WS_WM2) + (((size_t)(e * 4 + (nb >> 3)) * (DFE / 128) + (kb >> 1)) * 256 + 32 * (nb & 7)) * 128 + 64 * (kb & 1), 128, 512.0f, scr, lane); }
    return true;
}

struct P1Item { const float* src; int ld, col0, k0; unsigned char* dst; const unsigned* cmax; bool ok; };
__device__ __forceinline__ void p1_item_load(f32x4 (&v)[8], const P1Item& it, int lane) {
    const int c4 = (lane & 7) * 4, kr = lane >> 3;
#pragma unroll
    for (int i = 0; i < 8; ++i) v[i] = __builtin_nontemporal_load((const f32x4*)(it.src + (size_t)(it.k0 + kr + 8 * i) * it.ld + it.col0 + c4));
}
__device__ __forceinline__ void p1_item_finish(const f32x4 (&v)[8], const P1Item& it, LAS float* scr, int lane) {
    const int c4 = (lane & 7) * 4, kr = lane >> 3, c = lane & 7;
#pragma unroll
    for (int i = 0; i < 8; ++i) { LAS float* p = scr + (kr + 8 * i) * 33 + c4; p[0] = v[i][0]; p[1] = v[i][1]; p[2] = v[i][2]; p[3] = v[i][3]; }
    LDS_WAIT(); asm volatile("" ::: "memory");
#pragma unroll
    for (int j = 0; j < 4; ++j) { const int n = (lane >> 3) + 8 * j;
        const float am = __uint_as_float(it.cmax[n]); const float sc = am > 0.f ? 127.0f / am : 0.f;
        const LAS float* s = scr + (8 * c) * 33 + n;
        u32x2 o; o.x = pk4_i8(s[0 * 33] * sc, s[1 * 33] * sc, s[2 * 33] * sc, s[3 * 33] * sc); o.y = pk4_i8(s[4 * 33] * sc, s[5 * 33] * sc, s[6 * 33] * sc, s[7 * 33] * sc);
        *(u32x2*)(it.dst + (size_t)n * D + 8 * c) = o; }
    LDS_WAIT(); asm volatile("" ::: "memory");
}
__device__ __forceinline__ void p1_rows3(const Args& a, int row0, int G, int lane) {
    const float* modv = (const float*)(a.ws + WS_MODV);
    unsigned char* H = (unsigned char*)(a.ws + WS_H);
    constexpr int NRW = 3;
    f32x4 xv[NRW][4], shv[NRW][4], scv[NRW][4];
#pragma unroll
    for (int q = 0; q < NRW; ++q) { const int row = row0 + q * G * NWAVES;
        if (row < HROWS) { const bool cx = row >= T;
            const float* xr = cx ? a.in[I_CTX] + (size_t)(row - T) * D : a.in[I_X] + (size_t)row * D;
            const float* mv = modv + (size_t)(cx ? 16 : (row >> 11)) * 6144;
#pragma unroll
            for (int j = 0; j < 4; ++j) { const int col = 4 * lane + 256 * j; xv[q][j] = __builtin_nontemporal_load((const f32x4*)(xr + col)); shv[q][j] = *(const f32x4*)(mv + col); scv[q][j] = *(const f32x4*)(mv + 1024 + col); } } }
#pragma unroll
    for (int q = 0; q < NRW; ++q) { const int row = row0 + q * G * NWAVES;
        if (row < HROWS) {
#pragma unroll
            for (int j = 0; j < 4; ++j) { const int col = 4 * lane + 256 * j;
                const f32x4 hv = xv[q][j] * (scv[q][j] + 1.0f) + shv[q][j];
                *(unsigned*)(H + (size_t)row * D + col) = cvt_pk4_fp8(hv[0], hv[1], hv[2], hv[3]); } } }
}
__device__ __forceinline__ void p1_rows4b(const Args& a, int b, int idx, int lane) {
    const float* mv = (const float*)(a.ws + WS_MODV) + (size_t)(b < 16 ? b : 16) * 6144;
    unsigned char* H = (unsigned char*)(a.ws + WS_H);
    const int r0 = b * 2048 + idx;
    const float* xr = (b < 16) ? a.in[I_X] + (size_t)r0 * D : a.in[I_CTX] + (size_t)(r0 - T) * D;
    f32x4 xv[4][4], shv[4], scv[4];
#pragma unroll
    for (int j = 0; j < 4; ++j) { const int col = 4 * lane + 256 * j; shv[j] = *(const f32x4*)(mv + col); scv[j] = *(const f32x4*)(mv + 1024 + col) + 1.0f; }
#pragma unroll
    for (int k = 0; k < 4; ++k)
#pragma unroll
        for (int j = 0; j < 4; ++j) xv[k][j] = __builtin_nontemporal_load((const f32x4*)(xr + (size_t)(512 * k) * D + 4 * lane + 256 * j));
#pragma unroll
    for (int k = 0; k < 4; ++k)
#pragma unroll
        for (int j = 0; j < 4; ++j) { const f32x4 hv = xv[k][j] * scv[j] + shv[j];
            *(unsigned*)(H + (size_t)(r0 + 512 * k) * D + 4 * lane + 256 * j) = cvt_pk4_fp8(hv[0], hv[1], hv[2], hv[3]); }
}
__device__ __forceinline__ void p1_modulate(const Args& a, LAS unsigned char* lds, int G, int bx) {
    const int tid = threadIdx.x, lane = tid & 63, wave = __builtin_amdgcn_readfirstlane(tid >> 6);
    LAS float* scr = (LAS float*)(lds + wave * 16384);
    P1Item it[3];
#pragma unroll
    for (int j = 0; j < 2; ++j) { const int r = (bx + j * G) * NWAVES + wave; it[j].ok = r < 16 * 176;
        const int rr = it[j].ok ? r : 0, kb = rr / 176, nb = rr % 176, t = nb >> 3, sub = nb & 7;
        it[j].src = sub < 4 ? a.in[I_W1] : a.in[I_W3]; it[j].ld = DFF; it[j].col0 = 128 * t + 32 * (sub & 3); it[j].k0 = 64 * kb; it[j].dst = (unsigned char*)(a.ws + WS_W13) + (size_t)(32 * nb) * D + 64 * kb; it[j].cmax = (const unsigned*)(a.ws + WS_CMAX13) + 32 * nb; }
    { const int r = (G - 1 - bx) * NWAVES + wave; it[2].ok = r < 16 * 96;
        const int rr = it[2].ok ? r : 0, kb = rr / 96, nb = rr % 96; int col0;
        if (nb < 32) col0 = 32 * nb; else { const int n2 = nb - 32, t = n2 >> 3, sub = n2 & 7; col0 = (sub < 4 ? 1024 : 2048) + 128 * t + 32 * (sub & 3); }
        it[2].src = a.in[I_CWIN]; it[2].ld = 3 * D; it[2].col0 = col0; it[2].k0 = 64 * kb; it[2].dst = (unsigned char*)(a.ws + WS_WCIN) + (size_t)(32 * nb) * D + 64 * kb; it[2].cmax = (const unsigned*)(a.ws + WS_CMAXCIN) + 32 * nb; }
    if (G == 256) {
        const int gw = bx * NWAVES + wave, bg = gw >> 9, idx = gw & 511;
#pragma unroll
        for (int k = 0; k < 3; ++k) { f32x4 v[8];
            if (it[k].ok) p1_item_load(v, it[k], lane);
            p1_rows4b(a, 4 * k + bg, idx, lane);
            if (it[k].ok) p1_item_finish(v, it[k], scr, lane); }
        p1_rows4b(a, 12 + bg, idx, lane);
        if (16 + bg < 18) p1_rows4b(a, 16 + bg, idx, lane);
        return;
    }
    const int rstep = 3 * G * NWAVES; int row0 = bx * NWAVES + wave;
#pragma unroll
    for (int k = 0; k < 3; ++k) { f32x4 v[8];
        if (it[k].ok) p1_item_load(v, it[k], lane);
        if (row0 < HROWS) { p1_rows3(a, row0, G, lane); row0 += rstep; }
        if (row0 < HROWS) { p1_rows3(a, row0, G, lane); row0 += rstep; }
        if (it[k].ok) p1_item_finish(v, it[k], scr, lane); }
    for (; row0 < HROWS; row0 += rstep) p1_rows3(a, row0, G, lane);
    for (int r = (bx + 2 * G) * NWAVES + wave; r < 16 * 176; r += G * NWAVES) { const int kb = r / 176, nb = r % 176, t = nb >> 3, sub = nb & 7;
        p0_transpose_item_i8(sub < 4 ? a.in[I_W1] : a.in[I_W3], DFF, 128 * t + 32 * (sub & 3), 64 * kb, (unsigned char*)(a.ws + WS_W13) + (size_t)(32 * nb) * D + 64 * kb, D, (const unsigned*)(a.ws + WS_CMAX13) + 32 * nb, scr, lane); }
    for (int r = (2 * G - 1 - bx) * NWAVES + wave; r < 16 * 96; r += G * NWAVES) { const int kb = r / 96, nb = r % 96; int col0;
        if (nb < 32) col0 = 32 * nb; else { const int n2 = nb - 32, t = n2 >> 3, sub = n2 & 7; col0 = (sub < 4 ? 1024 : 2048) + 128 * t + 32 * (sub & 3); }
        p0_transpose_item_i8(a.in[I_CWIN], 3 * D, col0, 64 * kb, (unsigned char*)(a.ws + WS_WCIN) + (size_t)(32 * nb) * D + 64 * kb, D, (const unsigned*)(a.ws + WS_CMAXCIN) + 32 * nb, scr, lane); }
}

typedef short s16x4 __attribute__((ext_vector_type(4)));
constexpr int AT_STR = 144;
template <int NCH>
__device__ __forceinline__ void attn_load(u32x4 (&kr)[5], u32x4 (&vr)[5], const bf16_t* Kg, const bf16_t* Vg, long row0, int lo, int hi, int kh, int tid) {
#pragma unroll
    for (int i = 0; i < NCH; ++i) { const int ch = tid + 512 * i, key = ch >> 3, part = ch & 7;
        kr[i] = (u32x4){0u, 0u, 0u, 0u}; vr[i] = (u32x4){0u, 0u, 0u, 0u};
        if (key >= lo && key < hi) { const size_t off = (size_t)(row0 + key) * 256 + kh * 64 + part * 8; kr[i] = *(const u32x4*)(Kg + off); vr[i] = *(const u32x4*)(Vg + off); } }
}
template <int NCH>
__device__ __forceinline__ void attn_store(LAS unsigned char* Ks, LAS unsigned char* Vs, const u32x4 (&kr)[5], const u32x4 (&vr)[5], int tid) {
#pragma unroll
    for (int i = 0; i < NCH; ++i) { const int ch = tid + 512 * i, key = ch >> 3, part = ch & 7;
        *(LAS u32x4*)(Ks + key * AT_STR + part * 16) = kr[i]; *(LAS u32x4*)(Vs + key * AT_STR + part * 16) = vr[i]; }
}
template <int NBLK, bool MASK>
__device__ __forceinline__ void attn_step(const LAS unsigned char* Ks, const LAS unsigned char* Vs, int kb0, const bf16x8 (&Qf)[4], f32x16 (&O)[2], float& m, float& l, int n, int h, int vtoff, int qi, int klo, int khi) {
    bf16x8 kf[NBLK][4];
#pragma unroll
    for (int b = 0; b < NBLK; ++b)
#pragma unroll
        for (int c = 0; c < 4; ++c) kf[b][c] = *(const LAS bf16x8*)(Ks + (32 * (kb0 + b) + n) * AT_STR + (16 * c + 8 * h) * 2);
    __builtin_amdgcn_sched_barrier(0);
    f32x16 s[NBLK];
#pragma unroll
    for (int b = 0; b < NBLK; ++b) {
#pragma unroll
        for (int i = 0; i < 16; ++i) s[b][i] = 0.f;
#pragma unroll
        for (int c = 0; c < 4; ++c) s[b] = __builtin_amdgcn_mfma_f32_32x32x16_bf16(kf[b][c], Qf[c], s[b], 0, 0, 0);
    }
    s16x4 vlo[2][2], vhi[2][2];
#pragma unroll
    for (int sp = 0; sp < 2; ++sp)
#pragma unroll
        for (int db = 0; db < 2; ++db) {
            const LAS unsigned char* vp = Vs + vtoff + (32 * kb0 + 16 * sp) * AT_STR + 64 * db;
            vlo[sp][db] = __builtin_amdgcn_ds_read_tr16_b64_v4i16((LAS s16x4*)vp); vhi[sp][db] = __builtin_amdgcn_ds_read_tr16_b64_v4i16((LAS s16x4*)(vp + 8 * AT_STR)); }
    __builtin_amdgcn_sched_barrier(0);
    if (MASK) {
#pragma unroll
        for (int b = 0; b < NBLK; ++b)
#pragma unroll
            for (int i = 0; i < 16; ++i) { const int key = 32 * (kb0 + b) + 8 * (i >> 2) + 4 * h + (i & 3);
                const bool ok = (key >= klo) && (key < khi) && (key >= qi - 128) && (key <= qi + 128);
                s[b][i] = ok ? s[b][i] : -1e30f; }
    }
    float mx = s[0][0];
#pragma unroll
    for (int b = 0; b < NBLK; ++b)
#pragma unroll
        for (int i = 0; i < 16; ++i) mx = fmaxf(mx, s[b][i]);
    mx = fmaxf(mx, __shfl_xor(mx, 32));
    const float mn = fmaxf(m, mx);
    const float alpha = __builtin_amdgcn_exp2f(m - mn);
    m = mn;
    float ps = 0.f;
#pragma unroll
    for (int b = 0; b < NBLK; ++b)
#pragma unroll
        for (int i = 0; i < 16; ++i) { s[b][i] = __builtin_amdgcn_exp2f(s[b][i] - mn); ps += s[b][i]; }
    l = l * alpha + ps;
#pragma unroll
    for (int i = 0; i < 16; ++i) { O[0][i] *= alpha; O[1][i] *= alpha; }
#pragma unroll
    for (int b = 0; b < NBLK; ++b) {
        bf16x8 pf[2];
#pragma unroll
        for (int sp = 0; sp < 2; ++sp) { u32x4 w; w.x = cvt_pk_bf16(s[b][8 * sp + 0], s[b][8 * sp + 1]); w.y = cvt_pk_bf16(s[b][8 * sp + 2], s[b][8 * sp + 3]); w.z = cvt_pk_bf16(s[b][8 * sp + 4], s[b][8 * sp + 5]); w.w = cvt_pk_bf16(s[b][8 * sp + 6], s[b][8 * sp + 7]); pf[sp] = __builtin_bit_cast(bf16x8, w); }
        bf16x8 vf[2][2];
#pragma unroll
        for (int sp = 0; sp < 2; ++sp)
#pragma unroll
            for (int db = 0; db < 2; ++db) vf[sp][db] = __builtin_shufflevector(vlo[sp][db], vhi[sp][db], 0, 1, 2, 3, 4, 5, 6, 7);
        if (b + 1 < NBLK) {
#pragma unroll
            for (int sp = 0; sp < 2; ++sp)
#pragma unroll
                for (int db = 0; db < 2; ++db) {
                    const LAS unsigned char* vp = Vs + vtoff + (32 * (kb0 + b + 1) + 16 * sp) * AT_STR + 64 * db;
                    vlo[sp][db] = __builtin_amdgcn_ds_read_tr16_b64_v4i16((LAS s16x4*)vp); vhi[sp][db] = __builtin_amdgcn_ds_read_tr16_b64_v4i16((LAS s16x4*)(vp + 8 * AT_STR)); }
        }
#pragma unroll
        for (int sp = 0; sp < 2; ++sp)
#pragma unroll
            for (int db = 0; db < 2; ++db) O[db] = __builtin_amdgcn_mfma_f32_32x32x16_bf16(vf[sp][db], pf[sp], O[db], 0, 0, 0);
    }
}
#define AT_BAR() do { asm volatile("s_waitcnt lgkmcnt(0)" ::: "memory"); __builtin_amdgcn_s_barrier(); asm volatile("" ::: "memory"); } while (0)
__device__ __forceinline__ void p3_attention(const Args& a, LAS unsigned char* lds, int G, int bx) {
    const int tid = threadIdx.x, lane = tid & 63, wid = __builtin_amdgcn_readfirstlane(tid >> 6), n = lane & 31, h = lane >> 5, g = wid >> 1, qs = wid & 1;
    LAS unsigned char* Ks = lds; LAS unsigned char* Vs = lds + 320 * AT_STR;
    const int vtoff = (4 * h + ((lane & 15) >> 2)) * AT_STR + (16 * ((lane >> 4) & 1) + 4 * (lane & 3)) * 2;
    const bf16_t* Q = (const bf16_t*)(a.ws + WS_Q); const bf16_t* Kb = (const bf16_t*)(a.ws + WS_K); const bf16_t* Vb = (const bf16_t*)(a.ws + WS_V);
    const bf16_t* KC = (const bf16_t*)(a.ws + WS_KC); const bf16_t* VC = (const bf16_t*)(a.ws + WS_VC); unsigned char* AO = (unsigned char*)(a.ws + WS_AO);
    u32x4 kr[5], vr[5];
    if (bx < 2048) { const int kh0 = (bx >> 5) & 3, b0 = bx >> 7; attn_load<4>(kr, vr, KC, VC, (long)b0 * CTX, 0, 256, kh0, tid); }
    for (int unit = bx; unit < 2048; unit += G) {
        const int qb = unit & 31, kh = (unit >> 5) & 3, b = unit >> 7, q0 = 64 * qb;
        const int head = 4 * kh + g;
        const size_t qrow = (size_t)b * SEQ + q0 + 32 * qs + n;
        bf16x8 Qf[4];
#pragma unroll
        for (int c = 0; c < 4; ++c) Qf[c] = __builtin_nontemporal_load((const bf16x8*)(Q + qrow * D + head * 64 + 16 * c + 8 * h));
        f32x16 O[2];
#pragma unroll
        for (int i = 0; i < 16; ++i) { O[0][i] = 0.f; O[1][i] = 0.f; }
        float m = a.in[I_SINK][head] * 1.44269504089f, l = (h == 0) ? 1.0f : 0.0f;
        const int klo = (q0 - 128 < 0) ? (128 - q0) : 0, khi = (q0 + 192 > SEQ) ? (SEQ - (q0 - 128)) : 320;
        const bool edge = (klo != 0) || (khi != 320);
        AT_BAR();
        attn_store<4>(Ks, Vs, kr, vr, tid);
        attn_load<5>(kr, vr, Kb, Vb, (long)b * SEQ + q0 - 128, klo, khi, kh, tid);
        AT_BAR();
#pragma unroll 1
        for (int kb = 0; kb < 8; kb += 2) attn_step<2, false>(Ks, Vs, kb, Qf, O, m, l, n, h, vtoff, 0, 0, 0);
        AT_BAR();
        attn_store<5>(Ks, Vs, kr, vr, tid);
        { const int nu = unit + G; if (nu < 2048) { const int kh1 = (nu >> 5) & 3, b1 = nu >> 7; attn_load<4>(kr, vr, KC, VC, (long)b1 * CTX, 0, 256, kh1, tid); } }
        AT_BAR();
        const int qi = 128 + 32 * qs + n;
        attn_step<2, true>(Ks, Vs, qs, Qf, O, m, l, n, h, vtoff, qi, klo, khi);
        if (edge) {
#pragma unroll 1
            for (int kb = qs + 2; kb < qs + 8; kb += 2) attn_step<2, true>(Ks, Vs, kb, Qf, O, m, l, n, h, vtoff, qi, klo, khi);
        } else {
#pragma unroll 1
            for (int kb = qs + 2; kb < qs + 8; kb += 2) attn_step<2, false>(Ks, Vs, kb, Qf, O, m, l, n, h, vtoff, qi, klo, khi);
        }
        attn_step<1, true>(Ks, Vs, qs + 8, Qf, O, m, l, n, h, vtoff, qi, klo, khi);
        l += __shfl_xor(l, 32);
        const float inv = 16.0f / l;
        unsigned char* op = AO + qrow * D + head * 64;
        unsigned wx[4], wy[4];
#pragma unroll
        for (int i4 = 0; i4 < 4; ++i4) {
            const unsigned w0 = cvt_pk4_fp8(O[0][4 * i4 + 0] * inv, O[0][4 * i4 + 1] * inv, O[0][4 * i4 + 2] * inv, O[0][4 * i4 + 3] * inv);
            const unsigned w1 = cvt_pk4_fp8(O[1][4 * i4 + 0] * inv, O[1][4 * i4 + 1] * inv, O[1][4 * i4 + 2] * inv, O[1][4 * i4 + 3] * inv);
            const auto sw = __builtin_amdgcn_permlane32_swap(w0, w1, false, false); wx[i4] = sw[0]; wy[i4] = sw[1]; }
        u32x4 lo, hi; lo.x = wx[0]; lo.y = wy[0]; lo.z = wx[1]; lo.w = wy[1]; hi.x = wx[2]; hi.y = wy[2]; hi.z = wx[3]; hi.w = wy[3];
        *(u32x4*)(op + 32 * h) = lo; *(u32x4*)(op + 32 * h + 16) = hi;
    }
}

template <int MODE, int HQ = 0  , bool XIN_BF = false, bool XOUT_BF = false, int XIS = D, int XOS = D  >
__device__ __forceinline__ void ln_phase(const Args& a, LAS unsigned char* lds, int G, int bx, const float* xin, float* xout, const bf16_t* mix, const float* gate  ,
                                         const float* lng, const float* lnb, const float* scn, const float* shn  , bf16_t* hout, float gscale = 1.0f, float* rsout = nullptr) {
    const int tid = threadIdx.x, lane = tid & 63, wave = tid >> 6;
    LAS float* wr_t = (LAS float*)lds;
    LAS int* tokE = (LAS int*)(lds + 32768);
    LAS float* tokL = (LAS float*)(lds + 32768 + 2048);
    (void)tokL;
    if (MODE == 1) { for (int idx = tid; idx < 8 * 1024; idx += 512) { const int e = idx >> 10, d = idx & 1023; wr_t[idx] = a.in[I_ROUTER][d * 8 + e]; } __syncthreads(); }
    const int nvb = (MODE == 1) ? 256 : 0;
    for (int vb0 = bx; vb0 < 256; vb0 += G) {
        const int vb = (G == 256) ? ((vb0 & 7) * 32 + (vb0 >> 3)) : vb0;
        const int bb = (vb * 128) >> 11;
        f32x4 gtv[4], lgv[4], lbv[4], lcv[4], ldv[4];
#pragma unroll
        for (int j = 0; j < 4; ++j) { const int col = 4 * lane + 256 * j;
            gtv[j] = *(const f32x4*)(gate + (size_t)bb * 6144 + col) * gscale; lgv[j] = *(const f32x4*)(lng + col); lbv[j] = *(const f32x4*)(lnb + col);
            if (MODE != 2) { const f32x4 s1 = *(const f32x4*)(scn + (size_t)bb * 6144 + col) + 1.0f; lcv[j] = lgv[j] * s1; ldv[j] = lbv[j] * s1 + *(const f32x4*)(shn + (size_t)bb * 6144 + col); }
            else { lcv[j] = lgv[j]; ldv[j] = lbv[j]; } }
        for (int rr = 0; rr < 16; ++rr) {
            const int lt = wave * 16 + rr, row = vb * 128 + lt;
            f32x4 t[4]; float s = 0.f;
            float g0 = 0.f, g1 = 0.f; size_t p0 = 0, p1 = 0;
            if (MODE == 2) { const float2 gg = ((const float2*)(a.ws + WS_TOKG))[row]; const int2 pp = ((const int2*)(a.ws + WS_TOKP))[row]; g0 = gg.x; g1 = gg.y; p0 = (size_t)pp.x; p1 = (size_t)pp.y; }
#pragma unroll
            for (int j = 0; j < 4; ++j) { const int col = 4 * lane + 256 * j;
                f32x4 x; if (XIN_BF) { const u32x2 xw = __builtin_nontemporal_load((const u32x2*)((const bf16_t*)xin + (size_t)row * XIS + col)); x[0] = bf_lo(xw.x); x[1] = bf_hi(xw.x); x[2] = bf_lo(xw.y); x[3] = bf_hi(xw.y); }
                else x = __builtin_nontemporal_load((const f32x4*)(xin + (size_t)row * XIS + col));
                f32x4 mf;
                if (MODE == 2) { const u32x2 y0 = __builtin_nontemporal_load((const u32x2*)(mix + p0 * D + col)), y1 = __builtin_nontemporal_load((const u32x2*)(mix + p1 * D + col));
                    mf[0] = g0 * bf_lo(y0.x) + g1 * bf_lo(y1.x); mf[1] = g0 * bf_hi(y0.x) + g1 * bf_hi(y1.x); mf[2] = g0 * bf_lo(y0.y) + g1 * bf_lo(y1.y); mf[3] = g0 * bf_hi(y0.y) + g1 * bf_hi(y1.y); }
                else { const u32x2 mw = __builtin_nontemporal_load((const u32x2*)(mix + (size_t)row * D + col)); mf[0] = bf_lo(mw.x); mf[1] = bf_hi(mw.x); mf[2] = bf_lo(mw.y); mf[3] = bf_hi(mw.y); }
                t[j] = x * ALPHA + gtv[j] * mf; s += (t[j][0] + t[j][1]) + (t[j][2] + t[j][3]); }
            const float mean = wave_sum(s) * (1.0f / D); float s2 = 0.f;
#pragma unroll
            for (int j = 0; j < 4; ++j) { t[j] = t[j] - mean; s2 += (t[j][0] * t[j][0] + t[j][1] * t[j][1]) + (t[j][2] * t[j][2] + t[j][3] * t[j][3]); }
            const float rstd = 1.0f / sqrtf(wave_sum(s2) * (1.0f / D) + LN_EPS);
            float lg[8];
#pragma unroll
            for (int e = 0; e < 8; ++e) lg[e] = 0.f;
            f32x4 hq[4];
#pragma unroll
            for (int j = 0; j < 4; ++j) { const int col = 4 * lane + 256 * j;
                const f32x4 dn = t[j] * rstd; const f32x4 y = dn * lgv[j] + lbv[j];
                if (XOUT_BF) { u32x2 yw; yw.x = cvt_pk_bf16(y[0], y[1]); yw.y = cvt_pk_bf16(y[2], y[3]); __builtin_nontemporal_store(yw, (u32x2*)((bf16_t*)xout + (size_t)row * XOS + col)); }
                else __builtin_nontemporal_store(y, (f32x4*)(xout + (size_t)row * XOS + col));
                if (MODE != 2) { const f32x4 hv = dn * lcv[j] + ldv[j];
                    hq[j] = hv;
                    if (MODE == 1 || HQ == 1) { *(unsigned*)((unsigned char*)hout + (size_t)row * D + col) = cvt_pk4_fp8(hv[0], hv[1], hv[2], hv[3]); }
                    else if (HQ == 0) { u32x2 w; w.x = cvt_pk_bf16(hv[0], hv[1]); w.y = cvt_pk_bf16(hv[2], hv[3]); *(u32x2*)(hout + (size_t)row * D + col) = w; }
                    if (MODE == 1) {
#pragma unroll
                        for (int e = 0; e < 8; ++e) { const f32x4 wv = *(const LAS f32x4*)(wr_t + e * 1024 + col); lg[e] += (hv[0] * wv[0] + hv[1] * wv[1]) + (hv[2] * wv[2] + hv[3] * wv[3]); } } } }
            if (MODE != 2 && HQ == 2) {
                float am = 0.f;
#pragma unroll
                for (int j = 0; j < 4; ++j) am = fmaxf(am, fmaxf(fmaxf(fabsf(hq[j][0]), fabsf(hq[j][1])), fmaxf(fabsf(hq[j][2]), fabsf(hq[j][3]))));
                am = wave_max(am);
                const float qs = am > 0.f ? 127.0f / am : 0.f;
#pragma unroll
                for (int j = 0; j < 4; ++j) *(unsigned*)((unsigned char*)hout + (size_t)row * D + 4 * lane + 256 * j) = pk4_i8(hq[j][0] * qs, hq[j][1] * qs, hq[j][2] * qs, hq[j][3] * qs);
                if (lane == 0) rsout[row] = am * (1.0f / 127.0f);
            }
            if (MODE == 1) {
#pragma unroll
                for (int e = 0; e < 8; ++e) lg[e] = wave_sum(lg[e]);
                int e0 = 0; float l0 = lg[0];
#pragma unroll
                for (int e = 1; e < 8; ++e) if (lg[e] > l0) { l0 = lg[e]; e0 = e; }
                int e1 = -1; float l1 = -3.0e38f;
#pragma unroll
                for (int e = 0; e < 8; ++e) if (e != e0 && lg[e] > l1) { l1 = lg[e]; e1 = e; }
                if (e1 < 0) { e1 = (e0 + 1) & 7; l1 = lg[e1]; }
                if (lane == 0) { tokE[lt * 2] = e0; tokE[lt * 2 + 1] = e1; const float ex = __expf(l1 - l0); const float gg0 = 1.0f / (1.0f + ex);
                    ((float2*)(a.ws + WS_TOKG))[row] = make_float2(gg0, ex * gg0); }
            }
        }
        if (MODE == 1) {
            __syncthreads();
            if (tid < 64) { const int e = tid >> 3, sg = tid & 7; int c = 0;
#pragma unroll 1
                for (int i = 0; i < 32; ++i) c += (tokE[sg * 32 + i] == e) ? 1 : 0;
                tokE[512 + tid] = c;
                asm volatile("s_waitcnt lgkmcnt(0)" ::: "memory"); __builtin_amdgcn_wave_barrier();
                c = 0;
#pragma unroll 1
                for (int s2 = 0; s2 < sg; ++s2) c += tokE[512 + e * 8 + s2];
#pragma unroll 1
                for (int i = 0; i < 32; ++i) { const int idx = sg * 32 + i; if (tokE[idx] == e) { tokE[256 + idx] = c; ++c; } }
                if (sg == 7) ((int*)(a.ws + WS_WGCNT))[vb * 8 + e] = c; }
            __syncthreads();
            if (tid < 128) { int4 v; v.x = tokE[2 * tid]; v.y = tokE[2 * tid + 1]; v.z = tokE[256 + 2 * tid]; v.w = tokE[256 + 2 * tid + 1]; ((int4*)(a.ws + WS_TOKE))[vb * 128 + tid] = v; }
            __syncthreads();
        }
    }
    (void)nvb;
}

__device__ __forceinline__ void p10_conv(const Args& a, int G, int bx) {
    const int tid = threadIdx.x, lane = tid & 63, wave = tid >> 6;
    const bf16_t* BG = (const bf16_t*)(a.ws + WS_BG); const bf16_t* U = (const bf16_t*)(a.ws + WS_U); bf16_t* Z = (bf16_t*)(a.ws + WS_Z);
    const float* cw = a.in[I_CW];
    f32x4 w0[2][2], w1[2][2], w2[2][2];
#pragma unroll
    for (int j = 0; j < 2; ++j)
#pragma unroll
        for (int hf = 0; hf < 2; ++hf) { const int col = 8 * lane + 512 * j + 4 * hf;
            w0[j][hf] = *(const f32x4*)(cw + col); w1[j][hf] = *(const f32x4*)(cw + D + col); w2[j][hf] = *(const f32x4*)(cw + 2 * D + col); }
    const u32x4 zero = {0u, 0u, 0u, 0u};
    for (int vb0 = bx; vb0 < 256; vb0 += G) {
        const int vb = (G == 256) ? ((vb0 & 7) * 32 + (vb0 >> 3)) : vb0;
        const int r0 = vb * 128 + wave * 16;
        u32x4 um[2], uc[2], un[2];
#pragma unroll
        for (int j = 0; j < 2; ++j) { const int col = 8 * lane + 512 * j;
            um[j] = (r0 & (SEQ - 1)) > 0 ? *(const u32x4*)(U + (size_t)(r0 - 1) * D + col) : zero;
            uc[j] = __builtin_nontemporal_load((const u32x4*)(U + (size_t)r0 * D + col)); }
        for (int rr = 0; rr < 16; ++rr) { const int row = r0 + rr, sq = row & (SEQ - 1);
            u32x4 bg[2];
#pragma unroll
            for (int j = 0; j < 2; ++j) { const int col = 8 * lane + 512 * j;
                un[j] = (sq < SEQ - 1) ? ((rr < 15) ? __builtin_nontemporal_load((const u32x4*)(U + (size_t)(row + 1) * D + col)) : *(const u32x4*)(U + (size_t)(row + 1) * D + col)) : zero;
                bg[j] = __builtin_nontemporal_load((const u32x4*)(BG + (size_t)row * D + col)); }
#pragma unroll
            for (int j = 0; j < 2; ++j) { const int col = 8 * lane + 512 * j; u32x4 o;
#pragma unroll
                for (int q = 0; q < 4; ++q) { const int hf = q >> 1, e = 2 * (q & 1);
                    const float y0 = w0[j][hf][e] * bf_lo(um[j][q]) + w1[j][hf][e] * bf_lo(uc[j][q]) + w2[j][hf][e] * bf_lo(un[j][q]);
                    const float y1 = w0[j][hf][e + 1] * bf_hi(um[j][q]) + w1[j][hf][e + 1] * bf_hi(uc[j][q]) + w2[j][hf][e + 1] * bf_hi(un[j][q]);
                    o[q] = cvt_pk_bf16(bf_lo(bg[j][q]) * y0, bf_hi(bg[j][q]) * y1); }
                *(u32x4*)(Z + (size_t)row * D + col) = o;
                um[j] = uc[j]; uc[j] = un[j]; }
        }
    }
}

__device__ __forceinline__ void p13_scatter(const Args& a, LAS unsigned char* lds, int G, int bx) {
    const int tid = threadIdx.x, lane = tid & 63, wave = tid >> 6;
    LAS int* tot = (LAS int*)lds;
    const int* wgcnt = (const int*)(a.ws + WS_WGCNT);
    for (int vb0 = bx; vb0 < 256; vb0 += G) {
        const int vb = (G == 256) ? ((vb0 & 7) * 32 + (vb0 >> 3)) : vb0;
        __syncthreads();
        {
          const int e = tid & 7, sg = tid >> 3; int ts = 0, ms = 0;
#pragma unroll
          for (int k = 0; k < 4; ++k) { const int w = sg * 4 + k; const int c = wgcnt[w * 8 + e]; ts += c; ms += (w < vb) ? c : 0; }
          ts += __shfl_xor(ts, 8); ms += __shfl_xor(ms, 8); ts += __shfl_xor(ts, 16); ms += __shfl_xor(ms, 16); ts += __shfl_xor(ts, 32); ms += __shfl_xor(ms, 32);
          if (lane < 8) { tot[32 + wave * 8 + lane] = ts; tot[96 + wave * 8 + lane] = ms; } }
        __syncthreads();
        if (tid < 8) { int t = 0, mine = 0;
#pragma unroll
            for (int w = 0; w < 8; ++w) { t += tot[32 + w * 8 + tid]; mine += tot[96 + w * 8 + tid]; }
            tot[tid] = t; tot[8 + tid] = mine; }
        __syncthreads();
        if (tid == 0) { int p = 0; for (int e = 0; e < 8; ++e) { tot[16 + e] = p; p += (tot[e] + 255) & ~255; } tot[24] = p;
            if (vb == 0) { int* ps = (int*)(a.ws + WS_PSTART); for (int e = 0; e < 9; ++e) ps[e] = tot[16 + e]; } }
        __syncthreads();
        const unsigned char* src = (const unsigned char*)(a.ws + WS_H3F8); unsigned char* HS = (unsigned char*)(a.ws + WS_HS8);
        for (int rr = 0; rr < 16; ++rr) { const int row = vb * 128 + wave * 16 + rr;
            const int4 ti = ((const int4*)(a.ws + WS_TOKE))[row];
            const int pos0 = tot[16 + ti.x] + tot[8 + ti.x] + ti.z, pos1 = tot[16 + ti.y] + tot[8 + ti.y] + ti.w;
            if (lane == 0) ((int2*)(a.ws + WS_TOKP))[row] = make_int2(pos0, pos1);
            const u32x4 v0 = __builtin_nontemporal_load((const u32x4*)(src + (size_t)row * D + 16 * lane));
            *(u32x4*)(HS + (size_t)pos0 * D + 16 * lane) = v0; *(u32x4*)(HS + (size_t)pos1 * D + 16 * lane) = v0; }
    }
}

constexpr int NPH = 17;
__global__ void __launch_bounds__(NWAVES * 64, 2) mk_fwd(Args args) {
    extern __shared__ __attribute__((aligned(16))) unsigned char lds_raw[];
    LAS unsigned char* lds = (LAS unsigned char*)lds_raw;
    volatile LAS unsigned* MISC = (volatile LAS unsigned*)(lds + MISC_OFF);
    const int tid = threadIdx.x, G = gridDim.x, bx = blockIdx.x;
    if (tid < 16) MISC[tid] = 0u;
    __syncthreads();
    unsigned char* ws = args.ws;
    const int lo = args.ph_lo, hi = args.ph_hi;
    XcdBarrier bar; bar.bar = (unsigned*)(ws + WS_CTL); bar.x = 0; bar.st = nullptr;
    if (hi - lo > 1) bar = xcd_barrier_post((unsigned*)(ws + WS_CTL), MISC + 8);
#define IN(k) (lo <= (k) && (k) < hi)
#define SHADOW_CAP 6
#define SEAM(k) do { if (IN(k) && IN((k) + 1)) { if ((k) < 12) { const bool lead_ = xcd_barrier_arrive(bar); if (!lead_) { const int wv_ = __builtin_amdgcn_readfirstlane((int)threadIdx.x >> 6); const int ln_ = (int)__builtin_amdgcn_mbcnt_hi(~0u, __builtin_amdgcn_mbcnt_lo(~0u, 0u)); bool more_ = moe_item(args, lds, wv_, ln_);   for (int it_ = 0; more_ && it_ < SHADOW_CAP; ++it_) { unsigned g_ = 0u; if (ln_ == 0) g_ = xb_ld(&bar.bar[XB_XGEN(bar.x)]); if ((unsigned)__builtin_amdgcn_readfirstlane(g_) != bar.st[2]) break; more_ = moe_item(args, lds, wv_, ln_); } } xcd_barrier_wait(bar); } else xcd_barrier(bar); } } while (0)
    const float* modv0 = (const float*)(ws + WS_MODV); const float* modv1 = modv0 + 17 * 6144;
    bf16_t* H = (bf16_t*)(ws + WS_H); bf16_t* MIX = (bf16_t*)(ws + WS_MIX);

#ifndef ZERO_MASK
#define ZERO_MASK 0
#endif
#ifndef REP_MASK
#define REP_MASK 0u
#endif
#define PHASE(k, ...) do { if (IN(k)) { { __VA_ARGS__ } if ((REP_MASK >> (k)) & 1u) { xcd_barrier(bar); { __VA_ARGS__ } } } SEAM(k); } while (0)
#define MOE_ORDER(S, nn) pg8::MoeOrder S; { const int* ps = (const int*)(ws + WS_PSTART); \
        S.pe0 = __builtin_amdgcn_readfirstlane(ps[1]) >> 8; S.pe1 = __builtin_amdgcn_readfirstlane(ps[2]) >> 8; S.pe2 = __builtin_amdgcn_readfirstlane(ps[3]) >> 8; S.pe3 = __builtin_amdgcn_readfirstlane(ps[4]) >> 8; \
        S.pe4 = __builtin_amdgcn_readfirstlane(ps[5]) >> 8; S.pe5 = __builtin_amdgcn_readfirstlane(ps[6]) >> 8; S.pe6 = __builtin_amdgcn_readfirstlane(ps[7]) >> 8; \
        S.np = __builtin_amdgcn_readfirstlane(ps[8]) >> 8; S.nN = (nn); S.G = G; S.c = bx; }
    PHASE(0, p0_prologue(args, lds, G, bx););
    PHASE(1, p1_modulate(args, lds, G, bx););
    PHASE(2,
        pg8::Gemm g{H, (const bf16_t*)(ws + WS_WQKV), D}; pg8::QkvOrder S{G, bx};
        pg8::EpiQKV E{(bf16_t*)(ws + WS_Q), (bf16_t*)(ws + WS_K), (bf16_t*)(ws + WS_V), (bf16_t*)(ws + WS_KC), (bf16_t*)(ws + WS_VC), (const LAS float*)(lds + MISC_OFF + 8192)};
        { ((LAS f32x4*)(lds + MISC_OFF + 8192))[tid] = ((const f32x4*)(ws + WS_ROPE))[tid]; __syncthreads(); }
        pg8::gemm_phase<1>(lds, g, S, E););
    PHASE(3, p3_attention(args, lds, G, bx););
    PHASE(4,
        pg8::Gemm g{(const bf16_t*)(ws + WS_AO), (const bf16_t*)(ws + WS_WO), D}; pg8::StaticOrder S; S.init(T / 256, D / 256, G, bx);
        pg8::EpiPlain8<0x77777777, 0x7B7B7B7B> E{MIX, D}; pg8::gemm_phase<1>(lds, g, S, E););
    PHASE(5, ln_phase<0, 2, false, true>(args, lds, G, bx, args.in[I_X], (float*)(ws + WS_XB), MIX, modv0 + 2048, args.in[I_LNG], args.in[I_LNB], modv0 + 4096, modv0 + 3072, H, (ZERO_MASK & 1) ? 0.f : 1.f, (float*)(ws + WS_RS1)););
    PHASE(6,
        pg8::Gemm g{H, (const bf16_t*)(ws + WS_W13), D}; pg8::StaticOrder S; S.init(T / 256, 2 * DFF / 256, G, bx);
        pg8::EpiSwiGLUi8 E{(unsigned char*)(ws + WS_ACT), DFF, (const float*)(ws + WS_RS1), (const unsigned*)(ws + WS_CMAX13)}; pg8::gemm_phase<2>(lds, g, S, E););
    PHASE(7,
        pg8::Gemm g{(const bf16_t*)(ws + WS_ACT), (const bf16_t*)(ws + WS_W2), DFF}; pg8::StaticOrder S; S.init(T / 256, D / 256, G, bx);
        pg8::EpiPlain8<0x76767676, 0x7F7F7F7F> E{MIX, D}; pg8::gemm_phase<1>(lds, g, S, E););
    PHASE(8, ln_phase<0, 2, true, true>(args, lds, G, bx, (const float*)(ws + WS_XB), (float*)(ws + WS_XB), MIX, modv0 + 5120, args.in[I_LNG] + D, args.in[I_LNB] + D, modv1 + 1024, modv1, H, (ZERO_MASK & 2) ? 0.f : 1.f, (float*)(ws + WS_RS2)););
    PHASE(9,
        pg8::Gemm g{H, (const bf16_t*)(ws + WS_WCIN), D}; pg8::StaticOrder S; S.init(T / 256, 3 * D / 256, G, bx);
        pg8::EpiConvIni8 E{(bf16_t*)(ws + WS_BG), (bf16_t*)(ws + WS_U), (const float*)(ws + WS_RS2), (const unsigned*)(ws + WS_CMAXCIN)}; pg8::gemm_phase<2>(lds, g, S, E););
    PHASE(10, p10_conv(args, G, bx););
    PHASE(11,
        pg8::Gemm g{(const bf16_t*)(ws + WS_Z), (const bf16_t*)(ws + WS_WCOUT), D}; pg8::StaticOrder S; S.init(T / 256, D / 256, G, bx);
        pg8::EpiPlain E{MIX, D, 1.0f}; pg8::gemm_phase<0>(lds, g, S, E););
    PHASE(12, ln_phase<1, false, true, true, D, 2 * D>(args, lds, G, bx, (const float*)(ws + WS_XB), (float*)((bf16_t*)args.out + D)  , MIX, modv1 + 2048, args.in[I_LNG] + 2 * D, args.in[I_LNB] + 2 * D, modv1 + 4096, modv1 + 3072, (bf16_t*)(ws + WS_H3F8), (ZERO_MASK & 4) ? 0.f : 1.f););
    PHASE(13, { const int wv_ = __builtin_amdgcn_readfirstlane((int)threadIdx.x >> 6); const int ln_ = (int)__builtin_amdgcn_mbcnt_hi(~0u, __builtin_amdgcn_mbcnt_lo(~0u, 0u)); while (moe_item(args, lds, wv_, ln_)) {} __syncthreads(); } p13_scatter(args, lds, G, bx););
    PHASE(14, MOE_ORDER(S, 28); pg8::Gemm g{(const bf16_t*)(ws + WS_HS8), (const bf16_t*)(ws + WS_WM13), D}; pg8::EpiSwiGLU8 E{(unsigned char*)(ws + WS_MACT8), DFE, 1.0f / 128.0f}; pg8::gemm_phase<1>(lds, g, S, E););
    PHASE(15, MOE_ORDER(S, 4); pg8::Gemm g{(const bf16_t*)(ws + WS_MACT8), (const bf16_t*)(ws + WS_WM2), DFE}; pg8::EpiPlain8<0x76767676, 0x7F7F7F7F> E{(bf16_t*)(ws + WS_Y), D}; pg8::gemm_phase<1, pg8::EpiPlain8<0x76767676, 0x7F7F7F7F>, pg8::MoeOrder, true>(lds, g, S, E););
    if (IN(16)) { ln_phase<2, 0, true, false, 2 * D, D>(args, lds, G, bx, (const float*)((const bf16_t*)args.out + D), args.out, (const bf16_t*)(ws + WS_Y), modv1 + 5120, args.in[I_LNG] + 3 * D, args.in[I_LNB] + 3 * D, nullptr, nullptr, nullptr, (ZERO_MASK & 8) ? 0.f : 1.f); }
#undef IN
#undef SEAM
}

extern "C" void kernel_launch(void* const* d_in, const int* in_sizes, int n_in, void* d_out, int out_size, void* d_ws, size_t ws_size, hipStream_t stream) {
    static int grid = 0;
    if (grid == 0) {
        if (n_in != 21 || out_size != T * D || ws_size < WS_END) { fprintf(stderr, "kernel_launch: unexpected problem (n_in %d out %d ws %zu need %zu)\n", n_in, out_size, ws_size, (size_t)WS_END); grid = -1; return; }
        int dev = 0, cus = 0;
        if (hipGetDevice(&dev) != hipSuccess || hipDeviceGetAttribute(&cus, hipDeviceAttributeMultiprocessorCount, dev) != hipSuccess) { grid = -1; return; }
        if (hipFuncSetAttribute((const void*)mk_fwd, hipFuncAttributeMaxDynamicSharedMemorySize, LDS_BYTES) != hipSuccess) { grid = -1; return; }
        int per_cu = 0;
        (void)hipOccupancyMaxActiveBlocksPerMultiprocessor(&per_cu, (const void*)mk_fwd, NWAVES * 64, LDS_BYTES);
        (void)hipGetLastError();
        grid = cus > 256 ? 256 : cus;
    }
    if (grid < 0) return;
    (void)hipMemsetAsync((char*)d_ws + WS_CTL, 0, CTL_ZERO_BYTES, stream);
    Args a{};
    for (int i = 0; i < 21; ++i) a.in[i] = (const float*)d_in[i];
    a.out = (float*)d_out; a.ws = (unsigned char*)d_ws;
#if MK_ONE_LAUNCH
    a.ph_lo = 0; a.ph_hi = NPH;
    hipLaunchKernelGGL(mk_fwd, dim3(grid), dim3(NWAVES * 64), LDS_BYTES, stream, a);
#else
    for (int p = 0; p < NPH; ++p) { a.ph_lo = p; a.ph_hi = p + 1; hipLaunchKernelGGL(mk_fwd, dim3(grid), dim3(NWAVES * 64), LDS_BYTES, stream, a); }
#endif
}
```
